# Optimizing an MI355X kernel written in HIP

```python
import jax, jax.numpy as jnp
from jax import lax
import numpy as np

D_MODEL = 1024
BATCH = 16
SEQ = 256
DEPTH = 2
DEC_BATCH = 4
DEC_SEQ = 1024
PAST_LEN = 256

GRID_W = 64
H_A = 8
DK_A = 128
DV_A = 128
H_B = 4
DK_B = 256
DV_B = 512
D_FF = 2816
CONV_W = 3
CHUNK = 16
ROPE_BASE = 10000.0
EPS = 1e-6
RET_DECAY_OFFSET_BWD = 0.5
SPLIT_SIZES = (H_A * DK_A, H_A * DK_A, H_A * DK_A, H_A * DV_A, H_A * DV_A,
               H_B * DK_B, H_B * DK_B, H_B * DV_B, H_B * DV_B, D_MODEL, D_MODEL)
IN_WIDTH = sum(SPLIT_SIZES)

kernel_name = "hgrn2_retention_diffusion_step"


def rmsnorm(x, g):
    xf = x.astype(jnp.float32)
    y = xf * lax.rsqrt(jnp.mean(xf * xf, axis=-1, keepdims=True) + EPS)
    return (y * g.astype(jnp.float32)).astype(x.dtype)


def to_heads(t, n_heads):
    b, s, _ = t.shape
    return t.reshape(b, s, n_heads, -1).transpose(0, 2, 1, 3)


def chunk_scan(q, k, v, log_a, s0):
    b_, h_, t_, dk = q.shape
    dv = v.shape[-1]
    n = t_ // CHUNK
    r = lambda t: t.reshape(b_, h_, n, CHUNK, t.shape[-1])
    q, k, v, log_a = r(q), r(k), r(v), r(log_a)
    cum = jnp.cumsum(log_a, axis=-2)
    cum_end = cum[..., -1:, :]
    diff = cum[..., :, None, :] - cum[..., None, :, :]
    lower = jnp.tril(jnp.ones((CHUNK, CHUNK), dtype=bool))[:, :, None]
    dec = jnp.where(lower, jnp.exp(jnp.minimum(diff, 0.0)), 0.0)
    scores = jnp.einsum('bhntd,bhnsd,bhntsd->bhnts', q, k, dec)
    o_intra = jnp.einsum('bhnts,bhnsv->bhntv', scores, v)
    q_dec = q * jnp.exp(cum)
    k_dec = k * jnp.exp(cum_end - cum)
    a_end = jnp.exp(cum_end[..., 0, :])

    def step(S, xs):
        qd, kd, vv, ae = xs
        o = jnp.einsum('bhtd,bhdv->bhtv', qd, S)
        S = ae[..., None] * S + jnp.einsum('bhtd,bhtv->bhdv', kd, vv)
        return S, o

    mv = lambda t: jnp.moveaxis(t, 2, 0)
    s_fin, o_inter = lax.scan(step, s0, (mv(q_dec), mv(k_dec), mv(v), mv(a_end)))
    o = o_intra + jnp.moveaxis(o_inter, 0, 2)
    return o.reshape(b_, h_, t_, dv), s_fin


def bidir_scan(q, k_f, k_b, v, la_f, la_b, s0_f, s0_b):
    flip = lambda t: jnp.flip(t, axis=2)
    o_f, s_f = chunk_scan(q, k_f, v, la_f, s0_f)
    o_b, s_b = chunk_scan(flip(q), flip(k_b), flip(v), flip(la_b), s0_b)
    return o_f + flip(o_b), s_f, s_b


def axial_rope(x):
    t_ = x.shape[2]
    rows = t_ // GRID_W
    r_idx = jnp.repeat(jnp.arange(rows), GRID_W).astype(jnp.float32)
    c_idx = jnp.tile(jnp.arange(GRID_W), rows).astype(jnp.float32)
    half = x.shape[-1] // 2
    quarter = half // 2
    inv = 1.0 / (ROPE_BASE ** (jnp.arange(quarter, dtype=jnp.float32) / quarter))

    def rot(xh, pos):
        ang = pos[:, None] * inv[None, :]
        cos, sin = jnp.cos(ang), jnp.sin(ang)
        x1, x2 = xh[..., :quarter], xh[..., quarter:]
        return jnp.concatenate([x1 * cos - x2 * sin, x1 * sin + x2 * cos], axis=-1)

    xf = x.astype(jnp.float32)
    return jnp.concatenate([rot(xf[..., :half], r_idx), rot(xf[..., half:], c_idx)], axis=-1)


def retention_log_decay(offset):
    return jnp.log1p(-jnp.exp2(-(5.0 + offset) - jnp.arange(H_B, dtype=jnp.float32)))


def gated_head_norm(o, g, dtype):
    o = o * lax.rsqrt(jnp.mean(o * o, axis=-1, keepdims=True) + EPS)
    b_, h_, t_, dv = o.shape
    o = o.transpose(0, 2, 1, 3).reshape(b_, t_, h_ * dv)
    return (o * jax.nn.silu(g.astype(jnp.float32))).astype(dtype)


def token_mixer(h, w_in, lb, p_a, p_b, w_out, s_hgrn, s_ret, latent):
    f32 = jnp.float32
    b_, t_, _ = h.shape
    proj = jnp.einsum('btd,de->bte', h, w_in)
    points = np.cumsum(SPLIT_SIZES)[:-1].tolist()
    q_a, z_f, z_b, i_a, g_a, q_b, k_b, v_b, g_b, gate_a, gate_b = jnp.split(proj, points, axis=-1)

    def forget(z, lb_dir):
        z = to_heads(z, H_A).astype(f32)
        lbd = lb_dir.reshape(H_A, 1, DK_A).astype(f32)
        log_f = jnp.logaddexp(jnp.log(lbd), jnp.log1p(-lbd) + jax.nn.log_sigmoid(z))
        key = (1.0 - lbd) * jax.nn.sigmoid(-z)
        return log_f, key

    la_f, kh_f = forget(z_f, lb[0])
    la_b, kh_b = forget(z_b, lb[1])
    qa = to_heads(q_a, H_A).astype(f32)
    va = to_heads(i_a, H_A).astype(f32)
    o_a, sa_f, sa_b = bidir_scan(qa, kh_f, kh_b, va, la_f, la_b,
                                 s_hgrn[:, 0].astype(f32), s_hgrn[:, 1].astype(f32))
    y_a = jnp.einsum('bte,ed->btd', gated_head_norm(o_a, g_a, h.dtype), p_a)

    qb = to_heads(q_b, H_B).astype(f32)
    kb = to_heads(k_b, H_B).astype(f32) * (DK_B ** -0.5)
    if latent:
        qb, kb = axial_rope(qb), axial_rope(kb)
    vb = to_heads(v_b, H_B).astype(f32)
    shape_b = (b_, H_B, t_, DK_B)
    lg_f = jnp.broadcast_to(retention_log_decay(0.0)[None, :, None, None], shape_b)
    lg_b = jnp.broadcast_to(retention_log_decay(RET_DECAY_OFFSET_BWD)[None, :, None, None], shape_b)
    o_b, sr_f, sr_b = bidir_scan(qb, kb, kb, vb, lg_f, lg_b,
                                 s_ret[:, 0].astype(f32), s_ret[:, 1].astype(f32))
    y_b = jnp.einsum('bte,ed->btd', gated_head_norm(o_b, g_b, h.dtype), p_b)

    merged = jax.nn.sigmoid(gate_a) * y_a + jax.nn.sigmoid(gate_b) * y_b
    y = jnp.einsum('btd,de->bte', merged, w_out)
    return y, jnp.stack([sa_f, sa_b], axis=1), jnp.stack([sr_f, sr_b], axis=1)


def conv_ffn(h, w_up, w_conv, b_conv, w_down):
    u = jnp.einsum('btd,df->btf', h, w_up)
    up = jnp.pad(u, ((0, 0), (1, 1), (0, 0)))
    u = up[:, :-2] * w_conv[0] + up[:, 1:-1] * w_conv[1] + up[:, 2:] * w_conv[2] + b_conv
    a, g = jnp.split(u, 2, axis=-1)
    return jnp.einsum('btf,fd->btd', jax.nn.silu(g) * a, w_down)


def modulation(cvec, w_mod, b_mod):
    m = jnp.einsum('bd,de->be', jax.nn.silu(cvec), w_mod) + b_mod
    return jnp.split(m[:, None, :], 6, axis=-1)


def trunk_layer(x, mods, n1, n2, w_in, lb, p_a, p_b, w_out, w_up, w_conv, b_conv, w_down, s_hgrn, s_ret, latent):
    sh1, sc1, gt1, sh2, sc2, gt2 = mods
    h = rmsnorm(x, n1) * (1.0 + sc1) + sh1
    y, st_hgrn, st_ret = token_mixer(h, w_in, lb, p_a, p_b, w_out, s_hgrn, s_ret, latent)
    x = x + gt1 * y
    h = rmsnorm(x, n2) * (1.0 + sc2) + sh2
    x = x + gt2 * conv_ffn(h, w_up, w_conv, b_conv, w_down)
    return x, st_hgrn, st_ret


def setup_inputs(seed: int = 0) -> dict:
    key = jax.random.key(seed)
    ks = jax.random.split(key, 20)
    nrm = lambda k, shape, s: jax.random.normal(k, shape, jnp.float32) * s
    return {
        "x_prompt": nrm(ks[0], (BATCH, SEQ, D_MODEL), 1.0),
        "x_sample": nrm(ks[1], (DEC_BATCH, DEC_SEQ, D_MODEL), 1.0),
        "state_hgrn": nrm(ks[2], (DEC_BATCH, DEPTH, 2, H_A, DK_A, DV_A), 0.5),
        "state_ret": nrm(ks[3], (DEC_BATCH, DEPTH, 2, H_B, DK_B, DV_B), 0.5),
        "c": nrm(ks[4], (DEC_BATCH, D_MODEL), 1.0),
        "c_ctx": nrm(ks[5], (D_MODEL,), 1.0),
        "norm1": 1.0 + nrm(ks[6], (DEPTH, D_MODEL), 0.02),
        "norm2": 1.0 + nrm(ks[7], (DEPTH, D_MODEL), 0.02),
        "final_norm": 1.0 + nrm(ks[8], (D_MODEL,), 0.02),
        "w_mod": nrm(ks[9], (DEPTH, D_MODEL, 6 * D_MODEL), 0.5 * D_MODEL ** -0.5),
        "b_mod": nrm(ks[10], (DEPTH, 6 * D_MODEL), 0.01),
        "w_in": nrm(ks[11], (DEPTH, D_MODEL, IN_WIDTH), D_MODEL ** -0.5),
        "hgrn_lb_raw": nrm(ks[12], (DEPTH, 2, H_A * DK_A), 1.0),
        "p_a": nrm(ks[13], (DEPTH, H_A * DV_A, D_MODEL), (H_A * DV_A) ** -0.5),
        "p_b": nrm(ks[14], (DEPTH, H_B * DV_B, D_MODEL), (H_B * DV_B) ** -0.5),
        "w_out": nrm(ks[15], (DEPTH, D_MODEL, D_MODEL), D_MODEL ** -0.5),
        "w_up": nrm(ks[16], (DEPTH, D_MODEL, 2 * D_FF), D_MODEL ** -0.5),
        "w_conv": nrm(ks[17], (DEPTH, CONV_W, 2 * D_FF), CONV_W ** -0.5),
        "b_conv": nrm(ks[18], (DEPTH, 2 * D_FF), 0.01),
        "w_down": nrm(ks[19], (DEPTH, D_FF, D_MODEL), D_FF ** -0.5),
    }


def reference(x_prompt, x_sample, state_hgrn, state_ret, c, c_ctx, norm1, norm2, final_norm,
              w_mod, b_mod, w_in, hgrn_lb_raw, p_a, p_b, w_out, w_up, w_conv, b_conv, w_down):
    sm = jax.nn.softmax(hgrn_lb_raw.astype(jnp.float32), axis=0)
    cum = jnp.cumsum(sm, axis=0)
    lower_bounds = cum - cum[0:1]

    x = x_prompt
    b_ctx = x_prompt.shape[0]
    zero_hgrn = jnp.zeros((b_ctx, 2, H_A, DK_A, DV_A), jnp.float32)
    zero_ret = jnp.zeros((b_ctx, 2, H_B, DK_B, DV_B), jnp.float32)
    hgrn_states, ret_states = [], []
    for l in range(DEPTH):
        mods = modulation(c_ctx[None, :], w_mod[l], b_mod[l])
        x, st_h, st_r = trunk_layer(x, mods, norm1[l], norm2[l], w_in[l], lower_bounds[l], p_a[l], p_b[l],
                                    w_out[l], w_up[l], w_conv[l], b_conv[l], w_down[l],
                                    zero_hgrn, zero_ret, False)
        hgrn_states.append(st_h)
        ret_states.append(st_r)
    y_prompt = rmsnorm(x, final_norm)
    new_state_hgrn = jnp.stack(hgrn_states, axis=1).astype(x_prompt.dtype)
    new_state_ret = jnp.stack(ret_states, axis=1).astype(x_prompt.dtype)

    x = x_sample
    for l in range(DEPTH):
        mods = modulation(c, w_mod[l], b_mod[l])
        x, _, _ = trunk_layer(x, mods, norm1[l], norm2[l], w_in[l], lower_bounds[l], p_a[l], p_b[l],
                              w_out[l], w_up[l], w_conv[l], b_conv[l], w_down[l],
                              state_hgrn[:, l], state_ret[:, l], True)
    y_sample = rmsnorm(x, final_norm)
    return (y_prompt, y_sample, new_state_hgrn, new_state_ret)
```

```cpp
#include <hip/hip_runtime.h>
#include <hip/hip_cooperative_groups.h>
#include <cstdio>
namespace cg = cooperative_groups;

typedef unsigned short bf16_t;
typedef short bf16x8 __attribute__((ext_vector_type(8)));
typedef float f32x4 __attribute__((ext_vector_type(4)));
typedef unsigned short u16x4 __attribute__((ext_vector_type(4)));
typedef unsigned short u16x8 __attribute__((ext_vector_type(8)));
typedef unsigned u32x4 __attribute__((ext_vector_type(4)));
typedef unsigned u32x2 __attribute__((ext_vector_type(2)));

#define DEV __device__ __forceinline__
#define LAS3 __attribute__((address_space(3)))

constexpr int D = 1024, NTOK = 8192, NCTX = 4096, INW = 13312, DFF = 2816, DFF2 = 5632;
constexpr int NTHR = 512;
constexpr int LDS_BYTES = 156 * 1024;
constexpr float EPS = 1e-6f;

constexpr size_t MB = 1024 * 1024;
constexpr size_t SZ_TOK_BF = (size_t)NTOK * 1024 * 2;
constexpr size_t OFF_WIN = 0;
constexpr size_t OFF_PA = OFF_WIN + (size_t)INW * 1024 * 2;
constexpr size_t OFF_PB = OFF_PA + (size_t)1024 * 1024 * 2;
constexpr size_t OFF_WOUT = OFF_PB + (size_t)1024 * 2048 * 2;
constexpr size_t OFF_WUP = OFF_WOUT + (size_t)1024 * 1024 * 2;
constexpr size_t OFF_WDN = OFF_WUP + (size_t)DFF2 * 1024 * 2;
constexpr size_t OFF_MODS = OFF_WDN + (size_t)1024 * DFF * 2;
constexpr size_t OFF_LB = OFF_MODS + 2 * 5 * 6144 * 4;
constexpr size_t OFF_ROPE = OFF_LB + 2 * 2 * 1024 * 4;
constexpr size_t OFF_H = ((OFF_ROPE + 64 * 64 * 2 * 4 + 4095) / 4096) * 4096;
constexpr size_t OFF_QA = OFF_H + SZ_TOK_BF;
constexpr size_t OFF_IA = OFF_QA + SZ_TOK_BF;
constexpr size_t OFF_GA = OFF_IA + SZ_TOK_BF;
constexpr size_t OFF_QB = OFF_GA + SZ_TOK_BF;
constexpr size_t OFF_KB = OFF_QB + SZ_TOK_BF;
constexpr size_t OFF_SGA = OFF_KB + SZ_TOK_BF;
constexpr size_t OFF_SGB = OFF_SGA + SZ_TOK_BF;
constexpr size_t OFF_VB = OFF_SGB + SZ_TOK_BF;
constexpr size_t OFF_GB = OFF_VB + 2 * SZ_TOK_BF;
constexpr size_t OFF_LFF = OFF_GB + 2 * SZ_TOK_BF;
constexpr size_t OFF_LFB = OFF_LFF + 2 * SZ_TOK_BF;
constexpr size_t OFF_OAF = OFF_LFB + 2 * SZ_TOK_BF;
constexpr size_t OFF_OAB = OFF_OAF + SZ_TOK_BF;
constexpr size_t OFF_OBF = OFF_OAB + SZ_TOK_BF;
constexpr size_t OFF_OBB = OFF_OBF + 2 * SZ_TOK_BF;
constexpr size_t OFF_BAR = OFF_OBB + 2 * SZ_TOK_BF;
constexpr size_t WS_END = OFF_BAR + 16384;
constexpr size_t OFF_OA = OFF_QA;
constexpr size_t OFF_OB = OFF_QB;
constexpr size_t OFF_MERGED = OFF_LFF;
constexpr size_t OFF_P = OFF_LFB;
constexpr size_t OFF_P1 = OFF_QA;
constexpr size_t OFF_UB = OFF_OAF;
constexpr size_t OFF_U = OFF_OAF;
constexpr size_t OFF_ACT = OFF_VB;

constexpr size_t OUT_Y = 0;
constexpr size_t OUT_SH = (size_t)NTOK * 1024;
constexpr size_t OUT_SR = OUT_SH + (size_t)16 * 2 * 2 * 8 * 128 * 128;

struct Params {
    const float *x_prompt, *x_sample, *state_hgrn, *state_ret, *c, *c_ctx, *norm1, *norm2, *final_norm, *w_mod, *b_mod, *w_in, *lb_raw, *p_a, *p_b, *w_out, *w_up,
        *w_conv, *b_conv, *w_down;
    float* out;
    unsigned char* ws;
};

typedef const __attribute__((address_space(4))) Params* KP;
DEV KP fresh(KP kp) { unsigned z; asm volatile("s_mov_b32 %0, 0" : "=s"(z)); return (KP)((const __attribute__((address_space(4))) char*)kp + z); }
DEV unsigned xb_add(unsigned* p, unsigned v) {
    unsigned old;
    asm volatile("global_atomic_add %0, %1, %2, off sc0\n\ts_waitcnt vmcnt(0)" : "=v"(old) : "v"(p), "v"(v) : "memory");
    return old;
}
DEV int otid() { int t = threadIdx.x; asm volatile("" : "+v"(t)); return t; }
typedef float f32x2n __attribute__((ext_vector_type(2)));
typedef __bf16 bf16x2n __attribute__((ext_vector_type(2)));
DEV unsigned pk2(float lo, float hi) { f32x2n v = {lo, hi}; return __builtin_bit_cast(unsigned, __builtin_convertvector(v, bf16x2n)); }
DEV bf16_t f2bf(float f) { return (bf16_t)(pk2(f, f) & 0xffffu); }
DEV void store_bf4(bf16_t* dst, f32x4 v) { u32x2 o; o[0] = pk2(v[0], v[1]); o[1] = pk2(v[2], v[3]); *(u32x2*)dst = o; }
DEV float bf2f(bf16_t b) { return __uint_as_float(((unsigned)b) << 16); }
DEV float sigmoidf_(float z) { return __builtin_amdgcn_rcpf(1.f + __expf(-z)); }
DEV float siluf_(float z) { return z * __builtin_amdgcn_rcpf(1.f + __expf(-z)); }
DEV float shfl_xor_l(float v, int o, int lane) { return __int_as_float(__builtin_amdgcn_ds_bpermute((lane ^ o) << 2, __float_as_int(v))); }
DEV float wave_sum(float v, int lane) {
#pragma unroll
    for (int o = 32; o > 0; o >>= 1) v += shfl_xor_l(v, o, lane);
    return v;
}
DEV int seq_row0(int s) { return s < 16 ? s * 256 : NCTX + (s - 16) * 1024; }
DEV int seq_len(int s) { return s < 16 ? 256 : 1024; }
DEV int row_modvec(int row) { return row < NCTX ? 0 : 1 + ((row - NCTX) >> 10); }

DEV void phase_mods(KP p, float* lds) {
    p = fresh(p);
    const int tid = otid();
    float* sv = lds;
    float* red = lds + 5 * 1024;
    for (int i = tid; i < 5 * 1024; i += NTHR) {
        int v = i >> 10, d = i & 1023;
        float cv = v == 0 ? p->c_ctx[d] : p->c[(v - 1) * 1024 + d];
        sv[i] = siluf_(cv);
    }
    __syncthreads();
    for (int it = blockIdx.x; it < 256; it += gridDim.x) {
        const int l = it >> 7, e0 = (it & 127) * 48;
        const int cq = tid % 12, r = tid / 12;
        f32x4 a0 = {0.f, 0.f, 0.f, 0.f}, a1 = a0, a2 = a0, a3 = a0, a4 = a0;
        if (r < 42) {
            const float* wp = p->w_mod + (size_t)l * 1024 * 6144 + e0 + 4 * cq;
#pragma unroll 4
            for (int d = r; d < 1024; d += 42) {
                const f32x4 w = __builtin_nontemporal_load((const f32x4*)(wp + (size_t)d * 6144));
                a0 += w * sv[d]; a1 += w * sv[1024 + d]; a2 += w * sv[2048 + d]; a3 += w * sv[3072 + d]; a4 += w * sv[4096 + d];
            }
            float* rp = red + (r * 12 + cq) * 20;
            *(f32x4*)(rp) = a0; *(f32x4*)(rp + 4) = a1; *(f32x4*)(rp + 8) = a2; *(f32x4*)(rp + 12) = a3; *(f32x4*)(rp + 16) = a4;
        }
        __syncthreads();
        if (tid < 240) {
            const int v = tid / 48, c = tid % 48;
            float sum = 0.f;
            for (int g = 0; g < 42; ++g) sum += red[(g * 12 + (c >> 2)) * 20 + v * 4 + (c & 3)];
            float* mods = (float*)(p->ws + OFF_MODS);
            mods[((size_t)l * 5 + v) * 6144 + e0 + c] = sum + p->b_mod[l * 6144 + e0 + c];
        }
        __syncthreads();
    }
    float* lb = (float*)(p->ws + OFF_LB);
    float* rope = (float*)(p->ws + OFF_ROPE);
    for (int i = blockIdx.x * NTHR + tid; i < 2048 + 4096; i += gridDim.x * NTHR) {
        if (i < 2048) {
            float r0 = p->lb_raw[i], r1 = p->lb_raw[2048 + i];
            lb[i] = 0.f;
            lb[2048 + i] = 1.f / (1.f + expf(r0 - r1));
        } else {
            int k = i - 2048, pos = k >> 6, j = k & 63;
            float inv = exp2f(-((float)j / 64.f) * 13.287712379549449f);
            float ang = (float)pos * inv;
            rope[2 * k] = __cosf(ang); rope[2 * k + 1] = __sinf(ang);
        }
    }
}

DEV int win_src_col(int n) {
    if (n < 5120 || n >= 7168) return n;
    const int e = n & 255, half = e >> 7, pp = e & 127, g = pp >> 3, r = pp & 7;
    const int orig = half * 128 + (r < 4 ? 4 * g + r : 64 + 4 * g + (r - 4));
    return (n - e) + orig;
}
DEV int wup_src_col(int n) {
    const int j = n >> 8, e = n & 255, q = e >> 3, r = e & 7;
    return r < 4 ? 128 * j + 4 * q + r : DFF + 128 * j + 4 * q + (r - 4);
}
DEV void convert_one(const float* W, int K, int N, bf16_t* Wt, int perm, int tile, float* lds) {
    const int nNt = N / 256;
    const int kt = tile / nNt, nt = tile % nNt;
    const int tid = otid();
    f32x4 v[8];
#pragma unroll
    for (int i = 0; i < 8; ++i) {
        const int idx = tid + NTHR * i, row = idx >> 6, c4 = idx & 63;
        const int srcc = perm == 2 ? (c4 < 32 ? 128 * nt + 4 * c4 : DFF + 128 * nt + 4 * (c4 - 32)) : nt * 256 + 4 * c4;
        v[i] = __builtin_nontemporal_load((const f32x4*)(W + (size_t)(kt * 64 + row) * N + srcc));
    }
#pragma unroll
    for (int i = 0; i < 8; ++i) {
        const int idx = tid + NTHR * i, row = idx >> 6, c4 = idx & 63;
        float* dp = lds + row * 257 + 4 * c4;
        dp[0] = v[i][0]; dp[1] = v[i][1]; dp[2] = v[i][2]; dp[3] = v[i][3];
    }
    __syncthreads();
    {
        const int k8 = tid & 7, nl = tid >> 3;
#pragma unroll
        for (int i = 0; i < 4; ++i) {
            const int n = nt * 256 + nl + 64 * i;
            const int sg = n & 255, pi = sg & 15;
            int np = (n & ~255) + 64 * ((sg >> 5) & 3) + 32 * (sg >> 7) + 8 * (pi >> 2) + 4 * ((sg >> 4) & 1) + (pi & 3);
            if (perm == 1 && n >= 1024 && n < 3072) np = (n & ~255) + 64 * ((sg >> 5) & 3) + 32 * (sg >> 7) + 16 * ((sg >> 4) & 1) + pi;
            int sc = (perm == 1 ? win_src_col(np) : np) - nt * 256;
            if (perm == 2) { const int e = np & 255, q = e >> 3, r = e & 7; sc = r < 4 ? 4 * q + r : 128 + 4 * q + (r - 4); }
            const float* sp = lds + (8 * k8) * 257 + sc;
            u32x4 o;
            o[0] = pk2(sp[0], sp[257]); o[1] = pk2(sp[2 * 257], sp[3 * 257]); o[2] = pk2(sp[4 * 257], sp[5 * 257]); o[3] = pk2(sp[6 * 257], sp[7 * 257]);
            *(u32x4*)(Wt + (size_t)n * K + kt * 64 + 8 * k8) = o;
        }
    }
    __syncthreads();
}
DEV void phase_convert(KP p, int l, float* lds) {
    p = fresh(p);
    for (int t = blockIdx.x; t < 1616; t += gridDim.x) {
        if (t < 832) convert_one(p->w_in + (size_t)l * 1024 * INW, 1024, INW, (bf16_t*)(p->ws + OFF_WIN), 1, t, lds);
        else if (t < 896) convert_one(p->p_a + (size_t)l * 1024 * 1024, 1024, 1024, (bf16_t*)(p->ws + OFF_PA), 0, t - 832, lds);
        else if (t < 1024) convert_one(p->p_b + (size_t)l * 2048 * 1024, 2048, 1024, (bf16_t*)(p->ws + OFF_PB), 0, t - 896, lds);
        else if (t < 1088) convert_one(p->w_out + (size_t)l * 1024 * 1024, 1024, 1024, (bf16_t*)(p->ws + OFF_WOUT), 0, t - 1024, lds);
        else if (t < 1440) convert_one(p->w_up + (size_t)l * 1024 * DFF2, 1024, DFF2, (bf16_t*)(p->ws + OFF_WUP), 2, t - 1088, lds);
        else convert_one(p->w_down + (size_t)l * DFF * 1024, DFF, 1024, (bf16_t*)(p->ws + OFF_WDN), 0, t - 1440, lds);
    }
}

DEV void phase_norm(KP p, int mode, int nwsel, int lmod, int gate_idx, int sc_idx, int sh_idx) {
    p = fresh(p);
    const int tid = otid(), wid = tid >> 6, lane = tid & 63;
    const float* nw = nwsel < 2 ? p->norm1 + nwsel * 1024 : (nwsel < 4 ? p->norm2 + (nwsel - 2) * 1024 : p->final_norm);
    float* xbuf = p->out + OUT_Y;
    const bf16_t* P = (const bf16_t*)(p->ws + OFF_P);
    const bf16_t* P1 = (const bf16_t*)(p->ws + OFF_P1);
    const float* mods = (const float*)(p->ws + OFF_MODS);
    bf16_t* h = (bf16_t*)(p->ws + OFF_H);
    const float* xp = p->x_prompt; const float* xs = p->x_sample;
    const int stride = gridDim.x * 8;
    for (int row0 = blockIdx.x * 8 + wid; row0 < NTOK; row0 += 2 * stride) {
        f32x4 x[2][4], sc[2][4], sh[2][4], w[4];
        float ss[2] = {0.f, 0.f};
#pragma unroll
        for (int i = 0; i < 4; ++i) w[i] = *(const f32x4*)(nw + lane * 4 + 256 * i);
#pragma unroll
        for (int r = 0; r < 2; ++r) {
            const int row = row0 + r * stride;
            if (row < NTOK) {
                const int v = row_modvec(row);
#pragma unroll
                for (int i = 0; i < 4; ++i) {
                    const int c = lane * 4 + 256 * i;
                    if (mode == 0) {
                        const float* src = row < NCTX ? xp + (size_t)row * 1024 : xs + (size_t)(row - NCTX) * 1024;
                        x[r][i] = *(const f32x4*)(src + c);
                    } else {
                        x[r][i] = *(const f32x4*)(xbuf + (size_t)row * 1024 + c);
                        const u16x4 q0 = *(const u16x4*)(P + (size_t)row * 1024 + c), q1 = *(const u16x4*)(P1 + (size_t)row * 1024 + c);
                        const f32x4 g = *(const f32x4*)(mods + ((size_t)(gate_idx >> 3) * 5 + v) * 6144 + (gate_idx & 7) * 1024 + c);
                        f32x4 pv; pv[0] = bf2f(q0[0]) + bf2f(q1[0]); pv[1] = bf2f(q0[1]) + bf2f(q1[1]); pv[2] = bf2f(q0[2]) + bf2f(q1[2]); pv[3] = bf2f(q0[3]) + bf2f(q1[3]);
                        x[r][i] = x[r][i] + g * pv;
                    }
                    if (mode != 2) {
                        sc[r][i] = *(const f32x4*)(mods + ((size_t)lmod * 5 + v) * 6144 + sc_idx * 1024 + c);
                        sh[r][i] = *(const f32x4*)(mods + ((size_t)lmod * 5 + v) * 6144 + sh_idx * 1024 + c);
                    }
                    ss[r] += x[r][i][0] * x[r][i][0] + x[r][i][1] * x[r][i][1] + x[r][i][2] * x[r][i][2] + x[r][i][3] * x[r][i][3];
                }
            }
        }
        ss[0] = wave_sum(ss[0], lane); ss[1] = wave_sum(ss[1], lane);
#pragma unroll
        for (int r = 0; r < 2; ++r) {
            const int row = row0 + r * stride;
            if (row < NTOK) {
                const float rstd = rsqrtf(ss[r] * (1.f / 1024.f) + EPS);
#pragma unroll
                for (int i = 0; i < 4; ++i) {
                    const int c = lane * 4 + 256 * i;
                    if (mode == 2) {
                        *(f32x4*)(xbuf + (size_t)row * 1024 + c) = x[r][i] * rstd * w[i];
                    } else {
                        *(f32x4*)(xbuf + (size_t)row * 1024 + c) = x[r][i];
                        store_bf4(h + (size_t)row * 1024 + c, x[r][i] * rstd * w[i] * (sc[r][i] + 1.f) + sh[r][i]);
                    }
                }
            }
        }
    }
}

struct Seg { const bf16_t* A; const bf16_t* Bt; int lda, ldb, K; };

DEV void gemm_seg_simple(f32x4 (&acc)[2][2][4][2], const Seg& s, int pm, int pn, bf16_t* lds) {
    const int tid = otid(), wid = tid >> 6, lane = tid & 63, wr = wid >> 2, wc = wid & 3, fr = lane & 15, fq = lane >> 4;
    bf16_t* sA = lds;
    bf16_t* sB = lds + 256 * 40;
    const int lr = tid >> 2, lc = (tid & 3) * 8;
    for (int k0 = 0; k0 < s.K; k0 += 32) {
#pragma unroll
        for (int i = 0; i < 2; ++i) {
            const int r = lr + 128 * i;
            *(bf16x8*)(sA + r * 40 + lc) = *(const bf16x8*)(s.A + (size_t)(pm * 256 + r) * s.lda + k0 + lc);
            *(bf16x8*)(sB + r * 40 + lc) = *(const bf16x8*)(s.Bt + (size_t)(pn * 256 + r) * s.ldb + k0 + lc);
        }
        __syncthreads();
        bf16x8 bfr[2][2];
#pragma unroll
        for (int bj = 0; bj < 2; ++bj)
#pragma unroll
            for (int n = 0; n < 2; ++n) bfr[bj][n] = *(const bf16x8*)(sB + (128 * bj + 32 * wc + 16 * n + fr) * 40 + fq * 8);
#pragma unroll
        for (int ai = 0; ai < 2; ++ai)
#pragma unroll
            for (int m = 0; m < 4; ++m) {
                const bf16x8 af = *(const bf16x8*)(sA + (128 * ai + 64 * wr + 16 * m + fr) * 40 + fq * 8);
#pragma unroll
                for (int bj = 0; bj < 2; ++bj)
#pragma unroll
                    for (int n = 0; n < 2; ++n) acc[ai][bj][m][n] = __builtin_amdgcn_mfma_f32_16x16x32_bf16(bfr[bj][n], af, acc[ai][bj][m][n], 0, 0, 0);
            }
        __syncthreads();
    }
}

template <class F>
DEV void for_acc(f32x4 (&acc)[2][2][4][2], int pm, int pn, F f) {
    const int tid = otid(), wid = tid >> 6, lane = tid & 63, wr = wid >> 2, wc = wid & 3, fr = lane & 15, fq = lane >> 4;
#pragma unroll
    for (int a = 0; a < 2; ++a)
#pragma unroll
        for (int b = 0; b < 2; ++b)
#pragma unroll
            for (int m = 0; m < 4; ++m)
#pragma unroll
                for (int n = 0; n < 2; ++n) f(pm * 256 + 128 * a + 64 * wr + 16 * m + fr, pn * 256 + 64 * wc + 32 * b + 8 * fq + 4 * n, acc[a][b][m][n]);
}
template <class F>
DEV void for_acc2(f32x4 (&acc)[2][2][4][2], int pm, int pn, F f) {
    const int tid = otid(), wid = tid >> 6, lane = tid & 63, wr = wid >> 2, wc = wid & 3, fr = lane & 15, fq = lane >> 4;
#pragma unroll
    for (int a = 0; a < 2; ++a)
#pragma unroll
        for (int b = 0; b < 2; ++b)
#pragma unroll
            for (int m = 0; m < 4; ++m) f(pm * 256 + 128 * a + 64 * wr + 16 * m + fr, pn * 256 + 64 * wc + 32 * b + 8 * fq, acc[a][b][m][0], acc[a][b][m][1]);
}
DEV void zero_acc(f32x4 (&acc)[2][2][4][2]) {
#pragma unroll
    for (int a = 0; a < 2; ++a)
#pragma unroll
        for (int b = 0; b < 2; ++b)
#pragma unroll
            for (int m = 0; m < 4; ++m)
#pragma unroll
                for (int n = 0; n < 2; ++n) acc[a][b][m][n] = (f32x4){0.f, 0.f, 0.f, 0.f};
}

template <class Epi>
DEV void gemm_phase_simple(int nM, int nN, const Seg s0, const Seg s1, bool two, const Epi& E, bf16_t* lds) {
    for (int u = blockIdx.x; u < nM * nN; u += gridDim.x) {
        const int pm = u % nM, pn = u / nM;
        f32x4 acc[2][2][4][2];
        zero_acc(acc);
        gemm_seg_simple(acc, s0, pm, pn, lds);
        if (two) {
            E.mid(acc, pm, pn);
            gemm_seg_simple(acc, s1, pm, pn, lds);
        }
        E.fin(acc, pm, pn);
    }
}

#define LAS __attribute__((address_space(3)))
constexpr int HTB = 128 * 64 * 2;
DEV int lds_byte(int r, int c) { const int st = (r >> 4) * 2 + (c >> 5), rr = r & 15, cc = c & 31, ob = rr * 64 + cc * 2; return st * 1024 + (ob ^ (((ob >> 9) & 1) << 5)); }
DEV void stage_rc(int b, int& R, int& C) { const int st = b / 1024, sb = b % 1024, swz = sb ^ (((sb >> 9) & 1) << 5); R = (st >> 1) * 16 + swz / 64; C = (st & 1) * 32 + (swz % 64) / 2; }
struct Step { const char* A; const char* B; unsigned lda, ldb; int nt, pm, pn, kind, half; };
struct Prog {
    const bf16_t *A0, *B0, *A1, *B1; int lda0, ldb0, K0, lda1, ldb1, K1a, K1b, mode, ks, bsame, pnmap;
    int nM, nN, nwg, G, c;
    int j, stp;
    DEV void tile_of(int t, int& pm, int& pn) const {
        int wgid = t; { const int q = nwg / 8, r = nwg % 8, xcd = wgid % 8, off = wgid / 8; wgid = (xcd < r ? xcd * (q + 1) : r * (q + 1) + (xcd - r) * q) + off; }
        const int nig = 8 * nN, gid = wgid / nig, fm = gid * 8, gsz = (nM - fm) < 8 ? (nM - fm) : 8;
        pm = fm + ((wgid % nig) % gsz); pn = (wgid % nig) / gsz;
        if (pnmap == 1) pn = pn < 16 ? pn : pn + 4;
        else if (pnmap == 2) pn = pn < 4 ? 16 + pn : 32 + pn;
    }
    DEV bool next(Step& st) {
        const long L = (long)j * G + c;
        if (L >= (long)nwg * ks) return false;
        const int u = (int)L, tile = u / ks, half = u % ks;
        tile_of(tile, st.pm, st.pn); st.half = half;
        if (mode == 0) {
            st.lda = lda0 * 2; st.ldb = ldb0 * 2; st.nt = K0 / 64; st.kind = 0;
            const bf16_t* a = (half && A1) ? A1 : A0 + (size_t)half * K0 * (A1 ? 0 : 1);
            const bf16_t* bq = B0 + (size_t)half * K0 * (bsame ? 0 : 1);
            st.A = (const char*)a + (size_t)st.pm * 256 * st.lda; st.B = (const char*)bq + (size_t)st.pn * 256 * st.ldb;
            ++j;
        } else {
            if (half == 0 && stp == 0) {
                st.lda = lda0 * 2; st.ldb = ldb0 * 2; st.nt = K0 / 64; st.kind = 1;
                st.A = (const char*)A0 + (size_t)st.pm * 256 * st.lda; st.B = (const char*)B0 + (size_t)st.pn * 256 * st.ldb;
                stp = 1;
            } else {
                st.lda = lda1 * 2; st.ldb = ldb1 * 2; st.kind = 0;
                const int koff = half ? K1a : 0; st.nt = (half ? K1b : K1a) / 64;
                st.A = (const char*)(A1 + koff) + (size_t)st.pm * 256 * st.lda; st.B = (const char*)(B1 + koff) + (size_t)st.pn * 256 * st.ldb;
                stp = 0; ++j;
            }
        }
        return true;
    }
};
template <class Epi>
DEV void gemm_phase8(LAS unsigned char* lds, Prog& S, const Epi& E) {
    const int tid = otid(), wid = __builtin_amdgcn_readfirstlane(tid >> 6), lane = tid & 63, wr = wid >> 2, wc = wid & 3, fr = lane & 15, fq = lane >> 4;
    unsigned sR[2], sC2[2];
#pragma unroll
    for (int i = 0; i < 2; ++i) { int R, C; stage_rc(tid * 16 + i * 8192, R, C); sR[i] = (unsigned)R; sC2[i] = (unsigned)C * 2u; }
    const size_t kstep = 128;
    const unsigned ldsw = (unsigned)wid * 1024u;
    const int aoff = lds_byte(wr * 64 + fr, fq * 8), boff = lds_byte(wc * 32 + fr, fq * 8);
#define G8_SA(b, h) (((b) * 2 + (h)) * HTB)
#define G8_SB(b, h) ((4 + (b) * 2 + (h)) * HTB)
#define G8_STAGE(bufoff, gbase, ld) do { _Pragma("unroll") for (int _i = 0; _i < 2; ++_i) \
        __builtin_amdgcn_global_load_lds((const unsigned*)((const char*)(gbase) + (size_t)(sR[_i] * (ld) + sC2[_i])), (LAS unsigned*)(lds + (bufoff) + ldsw + _i * 8192), 16, 0, 0); } while (0)
#define G8_LDA(dst, b, h) do { _Pragma("unroll") for (int m = 0; m < 4; ++m) _Pragma("unroll") for (int k = 0; k < 2; ++k) dst[m][k] = *(const LAS bf16x8*)(lds + G8_SA(b, h) + aoff + m * 2048 + k * 1024); } while (0)
#define G8_LDB(dst, b, h) do { _Pragma("unroll") for (int n = 0; n < 2; ++n) _Pragma("unroll") for (int k = 0; k < 2; ++k) dst[n][k] = *(const LAS bf16x8*)(lds + G8_SB(b, h) + boff + n * 2048 + k * 1024); } while (0)
#define G8_MMA(ai, bj, At, Bt) do { __builtin_amdgcn_s_setprio(1); _Pragma("unroll") for (int m = 0; m < 4; ++m) _Pragma("unroll") for (int n = 0; n < 2; ++n) _Pragma("unroll") for (int k = 0; k < 2; ++k) \
        acc[ai][bj][m][n] = __builtin_amdgcn_mfma_f32_16x16x32_bf16(Bt[n][k], At[m][k], acc[ai][bj][m][n], 0, 0, 0); __builtin_amdgcn_s_setprio(0); } while (0)
#define G8_WAIT_V(n) asm volatile("s_waitcnt vmcnt(" #n ")" ::: "memory")
#define G8_WAIT_L(n) asm volatile("s_waitcnt lgkmcnt(" #n ")" ::: "memory")
#define G8_BAR __builtin_amdgcn_s_barrier()
#define G8_SCHED __builtin_amdgcn_sched_barrier(0)
    Step cur, nxt;
    if (!S.next(cur)) return;
    f32x4 acc[2][2][4][2];
    zero_acc(acc);
    bf16x8 At[4][2], B0[2][2], B1[2][2];
    {
        const char* cA = cur.A; const char* cB = cur.B; const unsigned la = cur.lda, lb = cur.ldb; const size_t hA = (size_t)128 * la, hB = (size_t)128 * lb;
        G8_STAGE(G8_SB(0, 0), cB, lb); G8_STAGE(G8_SA(0, 0), cA, la); G8_STAGE(G8_SB(0, 1), cB + hB, lb); G8_STAGE(G8_SA(0, 1), cA + hA, la);
        if (wr == 1) G8_BAR;
        G8_WAIT_V(4); G8_BAR;
        G8_STAGE(G8_SB(1, 0), cB + kstep, lb); G8_STAGE(G8_SA(1, 0), cA + kstep, la); G8_STAGE(G8_SB(1, 1), cB + hB + kstep, lb);
        G8_WAIT_V(6); G8_BAR;
    }
    for (;;) {
        const bool has_next = S.next(nxt);
        if (!has_next) nxt = cur;
        const char* cA = cur.A; const char* cB = cur.B; const unsigned la = cur.lda, lb = cur.ldb; const size_t hA = (size_t)128 * la, hB = (size_t)128 * lb;
        const int nt = cur.nt;
        for (int t = 0; t < nt; t += 2) {
            const bool last = (t == nt - 2);
            const char* a1 = cA + (size_t)(t + 1) * kstep;
            const char* a2 = last ? nxt.A : cA + (size_t)(t + 2) * kstep; const char* b2 = last ? nxt.B : cB + (size_t)(t + 2) * kstep;
            const unsigned la2 = last ? nxt.lda : la, lb2 = last ? nxt.ldb : lb; const size_t hA2 = (size_t)128 * la2, hB2 = (size_t)128 * lb2;
            const char* a3 = a2 + kstep; const char* b3 = b2 + kstep;
            G8_LDB(B0, 0, 0); G8_SCHED; G8_LDA(At, 0, 0); G8_STAGE(G8_SA(1, 1), a1 + hA, la);
            G8_WAIT_L(8); G8_BAR; G8_WAIT_L(0); G8_MMA(0, 0, At, B0); G8_BAR; G8_SCHED;
            G8_LDB(B1, 0, 1); G8_STAGE(G8_SB(0, 0), b2, lb2);
            G8_BAR; G8_WAIT_L(0); G8_MMA(0, 1, At, B1); G8_BAR;
            G8_LDA(At, 0, 1); G8_STAGE(G8_SA(0, 0), a2, la2);
            G8_BAR; G8_WAIT_L(0); G8_MMA(1, 0, At, B0); G8_BAR; G8_SCHED;
            G8_STAGE(G8_SB(0, 1), b2 + hB2, lb2);
            G8_WAIT_V(6); G8_BAR; G8_MMA(1, 1, At, B1); G8_BAR;
            G8_LDB(B0, 1, 0); G8_SCHED; G8_LDA(At, 1, 0); G8_STAGE(G8_SA(0, 1), a2 + hA2, la2);
            G8_WAIT_L(8); G8_BAR; G8_WAIT_L(0); G8_MMA(0, 0, At, B0); G8_BAR; G8_SCHED;
            G8_LDB(B1, 1, 1); G8_STAGE(G8_SB(1, 0), b3, lb2);
            G8_BAR; G8_WAIT_L(0); G8_MMA(0, 1, At, B1); G8_BAR;
            G8_LDA(At, 1, 1); G8_STAGE(G8_SA(1, 0), a3, la2);
            G8_BAR; G8_WAIT_L(0); G8_MMA(1, 0, At, B0); G8_BAR; G8_SCHED;
            G8_STAGE(G8_SB(1, 1), b3 + hB2, lb2);
            G8_WAIT_V(6); G8_BAR; G8_MMA(1, 1, At, B1); G8_BAR;
        }
        if (cur.kind == 1) E.mid(acc, cur.pm, cur.pn);
        else { E.fin(acc, cur.pm, cur.pn, cur.half); }
        if (!has_next) break;
        if (cur.kind == 0) zero_acc(acc);
        cur = nxt;
    }
    G8_WAIT_V(0);
    if (wr == 0) G8_BAR;
    G8_BAR;
#undef G8_SA
#undef G8_SB
#undef G8_STAGE
#undef G8_LDA
#undef G8_LDB
#undef G8_MMA
#undef G8_WAIT_V
#undef G8_WAIT_L
#undef G8_BAR
#undef G8_SCHED
}
template <class Epi>
DEV void gemm_run(Prog S, int nM, int nN, const Epi& E, bf16_t* ldsg) {
    S.nM = nM; S.nN = nN; S.nwg = nM * nN; S.G = gridDim.x; S.c = blockIdx.x; S.j = 0; S.stp = 0;
    gemm_phase8((LAS unsigned char*)ldsg, S, E);
}
template <class Epi>
DEV void gemm_one(Prog S, int nM, int nN, int unit, const Epi& E, bf16_t* ldsg) {
    S.nM = nM; S.nN = nN; S.nwg = nM * nN; S.G = 1 << 24; S.c = unit; S.j = 0; S.stp = 0;
    gemm_phase8((LAS unsigned char*)ldsg, S, E);
}
DEV Prog prog_plain(const bf16_t* A, const bf16_t* Bt, int lda, int ldb, int K) {
    Prog S; S.A0 = A; S.B0 = Bt; S.A1 = nullptr; S.B1 = nullptr; S.lda0 = lda; S.ldb0 = ldb; S.K0 = K; S.lda1 = 0; S.ldb1 = 0; S.K1a = 0; S.K1b = 0; S.mode = 0; S.ks = 1; S.bsame = 0; S.pnmap = 0; return S;
}


DEV u32x4 pack8(f32x4 v0, f32x4 v1) { u32x4 o; o[0] = pk2(v0[0], v0[1]); o[1] = pk2(v0[2], v0[3]); o[2] = pk2(v1[0], v1[1]); o[3] = pk2(v1[2], v1[3]); return o; }
DEV void stage_rows(bf16_t* dst, int ld, int rowbase, int colbase, u32x4 v0, u32x4 v1, int w, int fr, int fq, int lane) {
    extern __shared__ __attribute__((aligned(16))) unsigned char smem_x[];
    unsigned char* st = smem_x + 131072 + w * 2304;
    *(u32x4*)(st + fr * 144 + 16 * fq) = v0;
    *(u32x4*)(st + fr * 144 + 64 + 16 * fq) = v1;
    __builtin_amdgcn_wave_barrier();
    const int r = lane >> 3, pc = lane & 7;
    const u32x4 o0 = *(const u32x4*)(st + r * 144 + 16 * pc), o1 = *(const u32x4*)(st + (8 + r) * 144 + 16 * pc);
    *(u32x4*)(dst + (size_t)(rowbase + r) * ld + colbase + 8 * pc) = o0;
    *(u32x4*)(dst + (size_t)(rowbase + 8 + r) * ld + colbase + 8 * pc) = o1;
    __builtin_amdgcn_wave_barrier();
}
template <class G>
DEV void store_tile_rows(f32x4 (&acc)[2][2][4][2], int pm, bf16_t* dst, int ld, int coloff, G g) {
    const int tid = otid(), wid = tid >> 6, lane = tid & 63, wr = wid >> 2, wc = wid & 3, fr = lane & 15, fq = lane >> 4;
#pragma unroll
    for (int a = 0; a < 2; ++a)
#pragma unroll
        for (int m = 0; m < 4; ++m)
            stage_rows(dst, ld, pm * 256 + 128 * a + 64 * wr + 16 * m, coloff + 64 * wc, pack8(g(acc[a][0][m][0]), g(acc[a][0][m][1])), pack8(g(acc[a][1][m][0]), g(acc[a][1][m][1])), wid, fr, fq, lane);
}
DEV float logf_gate(float z, float lb) {
    const float e = __expf(-fabsf(z));
    const float r = __builtin_amdgcn_rcpf(1.f + e);
    const float sig = z >= 0.f ? r : e * r;
    return __builtin_amdgcn_logf(lb + (1.f - lb) * sig) * 0.6931471805599453f;
}

struct EpiInProj {
    unsigned char* ws; int l;
    DEV void mid(f32x4 (&)[2][2][4][2], int, int) const {}
    DEV void fin(f32x4 (&acc)[2][2][4][2], int pm, int pn, int half) const {
        const int col0 = pn * 256;
        unsigned char* w = ws; const int ll = l;
        if (col0 < 1024) { store_tile_rows(acc, pm, (bf16_t*)(w + OFF_QA), 1024, pn * 256 - 0, [](f32x4 v) { return v; }); }
        else if (col0 < 3072) {
            const int dir = col0 >= 2048;
            const float* lbp = (const float*)(w + OFF_LB) + (ll * 2 + dir) * 1024;
            float* dst = (float*)(w + (dir ? OFF_LFB : OFF_LFF));
            {
                const int tid = otid(), wid = tid >> 6, lane = tid & 63, wr = wid >> 2, wc = wid & 3, fr = lane & 15, fq = lane >> 4;
                const int cb = pn * 256 - 1024 - dir * 1024 + 64 * wc + 4 * fq;
                f32x4 lb4[2][2];
#pragma unroll
                for (int b = 0; b < 2; ++b)
#pragma unroll
                    for (int n = 0; n < 2; ++n) lb4[b][n] = *(const f32x4*)(lbp + cb + 32 * b + 16 * n);
#pragma unroll
                for (int a = 0; a < 2; ++a)
#pragma unroll
                    for (int m = 0; m < 4; ++m)
#pragma unroll
                        for (int b = 0; b < 2; ++b)
#pragma unroll
                            for (int n = 0; n < 2; ++n) {
                                const int row = pm * 256 + 128 * a + 64 * wr + 16 * m + fr;
                                f32x4 o;
#pragma unroll
                                for (int j = 0; j < 4; ++j) o[j] = logf_gate(acc[a][b][m][n][j], lb4[b][n][j]);
                                *(f32x4*)(dst + (size_t)row * 1024 + cb + 32 * b + 16 * n) = o;
                            }
            }
        }
        else if (col0 < 4096) { store_tile_rows(acc, pm, (bf16_t*)(w + OFF_IA), 1024, pn * 256 - 3072, [](f32x4 v) { return v; }); }
        else if (col0 < 5120) { store_tile_rows(acc, pm, (bf16_t*)(w + OFF_GA), 1024, pn * 256 - 4096, [](f32x4 v) { return v; }); }
        else if (col0 < 7168) {
            const int isk = col0 >= 6144;
            const float scale = isk ? 0.0625f : 1.f;
            bf16_t* dbase = (bf16_t*)(w + (isk ? OFF_KB : OFF_QB));
            const float* rope = (const float*)(w + OFF_ROPE);
            {
                const int tid = otid(), wid = tid >> 6, lane = tid & 63, wr = wid >> 2, wc = wid & 3, fr = lane & 15, fq = lane >> 4;
#pragma unroll
                for (int a = 0; a < 2; ++a) {
                    f32x4 cs0[2][4], cs1[2][4];
#pragma unroll
                    for (int b = 0; b < 2; ++b)
#pragma unroll
                        for (int m = 0; m < 4; ++m) {
                            const int row = pm * 256 + 128 * a + 64 * wr + 16 * m + fr;
                            const int g = 8 * (wc & 1) + 4 * b + fq;
                            const int t = (row - NCTX) & 1023, pos = (wc >> 1) ? (t & 63) : (t >> 6);
                            cs0[b][m] = *(const f32x4*)(rope + (pos * 64 + 4 * g) * 2); cs1[b][m] = *(const f32x4*)(rope + (pos * 64 + 4 * g) * 2 + 4);
                        }
#pragma unroll
                    for (int b = 0; b < 2; ++b)
#pragma unroll
                        for (int m = 0; m < 4; ++m) {
                            const int row = pm * 256 + 128 * a + 64 * wr + 16 * m + fr;
                            const int g = 8 * (wc & 1) + 4 * b + fq, hh = pn & 3;
                            const f32x4 x1 = acc[a][b][m][0] * scale, x2 = acc[a][b][m][1] * scale;
                            f32x4 o1 = x1, o2 = x2;
                            if (row >= NCTX) {
                                const f32x4 c0 = cs0[b][m], c1 = cs1[b][m];
                                o1[0] = x1[0] * c0[0] - x2[0] * c0[1]; o2[0] = x1[0] * c0[1] + x2[0] * c0[0];
                                o1[1] = x1[1] * c0[2] - x2[1] * c0[3]; o2[1] = x1[1] * c0[3] + x2[1] * c0[2];
                                o1[2] = x1[2] * c1[0] - x2[2] * c1[1]; o2[2] = x1[2] * c1[1] + x2[2] * c1[0];
                                o1[3] = x1[3] * c1[2] - x2[3] * c1[3]; o2[3] = x1[3] * c1[3] + x2[3] * c1[2];
                            }
                            bf16_t* dstp = dbase + (size_t)row * 1024 + hh * 256 + (wc >> 1) * 128 + 4 * g;
                            store_bf4(dstp, o1);
                            store_bf4(dstp + 64, o2);
                        }
                }
            }
        }
        else if (col0 < 9216) { store_tile_rows(acc, pm, (bf16_t*)(w + OFF_VB), 2048, pn * 256 - 7168, [](f32x4 v) { return v; }); }
        else if (col0 < 11264) { store_tile_rows(acc, pm, (bf16_t*)(w + OFF_GB), 2048, pn * 256 - 9216, [](f32x4 v) { return v; }); }
        else {
            const int isb = col0 >= 12288;
            bf16_t* dbase = (bf16_t*)(w + (isb ? OFF_SGB : OFF_SGA));
            store_tile_rows(acc, pm, dbase, 1024, pn * 256 - 11264 - isb * 1024, [](f32x4 v) { f32x4 o; o[0] = sigmoidf_(v[0]); o[1] = sigmoidf_(v[1]); o[2] = sigmoidf_(v[2]); o[3] = sigmoidf_(v[3]); return o; });
        }
    }
};
struct EpiMerged {
    unsigned char* ws;
    DEV void mid(f32x4 (&acc)[2][2][4][2], int pm, int pn) const {
        const bf16_t* sga = (const bf16_t*)(ws + OFF_SGA); const bf16_t* sgb = (const bf16_t*)(ws + OFF_SGB);
        for_acc(acc, pm, pn, [&](int row, int col, f32x4& v) {
            const u16x4 a = *(const u16x4*)(sga + (size_t)row * 1024 + col);
            const u16x4 b = *(const u16x4*)(sgb + (size_t)row * 1024 + col);
#pragma unroll
            for (int j = 0; j < 4; ++j) v[j] *= bf2f(a[j]) * __builtin_amdgcn_rcpf(fmaxf(bf2f(b[j]), 1e-30f));
        });
    }
    DEV void fin(f32x4 (&acc)[2][2][4][2], int pm, int pn, int half) const {
        const bf16_t* sgb = (const bf16_t*)(ws + OFF_SGB); bf16_t* mg = (bf16_t*)(ws + OFF_MERGED) + (size_t)half * NTOK * 1024;
        const int tid = otid(), wid = tid >> 6, lane = tid & 63, wr = wid >> 2, wc = wid & 3, fr = lane & 15, fq = lane >> 4;
        const int cb = pn * 256 + 64 * wc + 8 * fq;
#pragma unroll
        for (int a = 0; a < 2; ++a) {
            u16x8 gb[2][4];
#pragma unroll
            for (int b = 0; b < 2; ++b)
#pragma unroll
                for (int m = 0; m < 4; ++m) gb[b][m] = *(const u16x8*)(sgb + (size_t)(pm * 256 + 128 * a + 64 * wr + 16 * m + fr) * 1024 + cb + 32 * b);
#pragma unroll
            for (int b = 0; b < 2; ++b)
#pragma unroll
                for (int m = 0; m < 4; ++m) {
                    const size_t off = (size_t)(pm * 256 + 128 * a + 64 * wr + 16 * m + fr) * 1024 + cb + 32 * b;
                    u32x4 o;
#pragma unroll
                    for (int n = 0; n < 2; ++n) {
                        const f32x4 v = acc[a][b][m][n];
                        o[2 * n] = pk2(v[0] * fmaxf(bf2f(gb[b][m][4 * n]), 1e-30f), v[1] * fmaxf(bf2f(gb[b][m][4 * n + 1]), 1e-30f));
                        o[2 * n + 1] = pk2(v[2] * fmaxf(bf2f(gb[b][m][4 * n + 2]), 1e-30f), v[3] * fmaxf(bf2f(gb[b][m][4 * n + 3]), 1e-30f));
                    }
                    *(u32x4*)(mg + off) = o;
                }
        }
    }
};
struct EpiF32 {
    float* C; float* C1; int ldc;
    DEV void mid(f32x4 (&)[2][2][4][2], int, int) const {}
    DEV void fin(f32x4 (&acc)[2][2][4][2], int pm, int pn, int half) const {
        float* c = half ? C1 : C; const int ld = ldc;
        for_acc(acc, pm, pn, [&](int row, int col, f32x4& v) { *(f32x4*)(c + (size_t)row * ld + col) = v; });
    }
};
struct EpiBf {
    bf16_t* C; bf16_t* C1; int ldc;
    DEV void mid(f32x4 (&)[2][2][4][2], int, int) const {}
    DEV void fin(f32x4 (&acc)[2][2][4][2], int pm, int pn, int half) const {
        bf16_t* c = half ? C1 : C; const int ld = ldc;
        store_tile_rows(acc, pm, c, ld, pn * 256, [](f32x4 v) { return v; });
    }
};

#define ROR1(x)  __int_as_float(__builtin_amdgcn_update_dpp(0, __float_as_int(x), 0x121, 0xf, 0xf, false))
#define ROR15(x) __int_as_float(__builtin_amdgcn_update_dpp(0, __float_as_int(x), 0x12F, 0xf, 0xf, false))
struct EpiUpConv {
    unsigned char* ws; const float* wc_; const float* bc_;
    DEV void mid(f32x4 (&)[2][2][4][2], int, int) const {}
    DEV void fin(f32x4 (&acc)[2][2][4][2], int pm, int pn, int) const {
        const int tid = otid(), wid = tid >> 6, lane = tid & 63, wr = wid >> 2, wc = wid & 3, fr = lane & 15, fq = lane >> 4;
        bf16_t* act = (bf16_t*)(ws + OFF_ACT); bf16_t* ub = (bf16_t*)(ws + OFF_UB);
        const int ip = ((lane & 48) | ((fr + 15) & 15)) << 2, in = ((lane & 48) | ((fr + 1) & 15)) << 2;
#pragma unroll
        for (int b = 0; b < 2; ++b) {
            const int ch = pn * 128 + 4 * (8 * wc + 4 * b + fq);
            const f32x4 wa0 = *(const f32x4*)(wc_ + ch), wa1 = *(const f32x4*)(wc_ + DFF2 + ch), wa2 = *(const f32x4*)(wc_ + 2 * DFF2 + ch), ba = *(const f32x4*)(bc_ + ch);
            const f32x4 wg0 = *(const f32x4*)(wc_ + DFF + ch), wg1 = *(const f32x4*)(wc_ + DFF2 + DFF + ch), wg2 = *(const f32x4*)(wc_ + 2 * DFF2 + DFF + ch), bg = *(const f32x4*)(bc_ + DFF + ch);
#pragma unroll
            for (int a = 0; a < 2; ++a)
#pragma unroll
                for (int m = 0; m < 4; ++m) {
                    const int row = pm * 256 + 128 * a + 64 * wr + 16 * m + fr;
                    f32x4 pa, na, pg, ng;
#pragma unroll
                    for (int j = 0; j < 4; ++j) {
                        const float ca = acc[a][b][m][0][j], cg = acc[a][b][m][1][j];
                        const float sa_p = (m > 0 && fr == 15) ? acc[a][b][m > 0 ? m - 1 : 0][0][j] : ((m == 0 && fr == 15) ? 0.f : ca);
                        const float sg_p = (m > 0 && fr == 15) ? acc[a][b][m > 0 ? m - 1 : 0][1][j] : ((m == 0 && fr == 15) ? 0.f : cg);
                        const float sa_n = (m < 3 && fr == 0) ? acc[a][b][m < 3 ? m + 1 : 3][0][j] : ((m == 3 && fr == 0) ? 0.f : ca);
                        const float sg_n = (m < 3 && fr == 0) ? acc[a][b][m < 3 ? m + 1 : 3][1][j] : ((m == 3 && fr == 0) ? 0.f : cg);
                        pa[j] = ROR1(sa_p); pg[j] = ROR1(sg_p);
                        na[j] = ROR15(sa_n); ng[j] = ROR15(sg_n);
                    }
                    const f32x4 va = ba + wa0 * pa + wa1 * acc[a][b][m][0] + wa2 * na;
                    const f32x4 vg = bg + wg0 * pg + wg1 * acc[a][b][m][1] + wg2 * ng;
                    f32x4 o;
#pragma unroll
                    for (int j = 0; j < 4; ++j) o[j] = siluf_(vg[j]) * va[j];
                    store_bf4(act + (size_t)row * DFF + ch, o);
                    const int pos = row & 63;
                    if (pos < 2 || pos >= 62) {
                        bf16_t* up = ub + (size_t)((row >> 6) * 4 + (pos < 2 ? pos : pos - 60)) * DFF2;
                        store_bf4(up + ch, acc[a][b][m][0]);
                        store_bf4(up + DFF + ch, acc[a][b][m][1]);
                    }
                }
        }
    }
};
DEV void conv_fixup(unsigned char* ws, const float* wc_, const float* bc_, int pm, int c0) {
    const int tid = otid();
    bf16_t* act = (bf16_t*)(ws + OFF_ACT); const bf16_t* ub = (const bf16_t*)(ws + OFF_UB);
    for (int idx = tid; idx < 8 * 352; idx += NTHR) {
        const int ri = idx / 352, cq = idx % 352, ch = c0 + 4 * cq;
        const int R = pm * 256 + (ri >> 1) * 64 + ((ri & 1) ? 63 : 0);
        const int t = R < NCTX ? (R & 255) : ((R - NCTX) & 1023), T = R < NCTX ? 256 : 1024;
        const int blk = R >> 6;
        const bf16_t *rp, *rc, *rn;
        if (ri & 1) { rp = ub + (size_t)(blk * 4 + 2) * DFF2; rc = ub + (size_t)(blk * 4 + 3) * DFF2; rn = ub + (size_t)((blk + 1) * 4 + 0) * DFF2; }
        else { rp = ub + (size_t)((blk - 1) * 4 + 3) * DFF2; rc = ub + (size_t)(blk * 4 + 0) * DFF2; rn = ub + (size_t)(blk * 4 + 1) * DFF2; }
        const bool hp = t > 0, hn = t < T - 1;
        f32x4 va = *(const f32x4*)(bc_ + ch), vg = *(const f32x4*)(bc_ + DFF + ch);
        {
            const u16x4 xa = *(const u16x4*)(rc + ch), xg = *(const u16x4*)(rc + DFF + ch);
            const f32x4 wa = *(const f32x4*)(wc_ + DFF2 + ch), wg = *(const f32x4*)(wc_ + DFF2 + DFF + ch);
#pragma unroll
            for (int j = 0; j < 4; ++j) { va[j] += wa[j] * bf2f(xa[j]); vg[j] += wg[j] * bf2f(xg[j]); }
        }
        if (hp) {
            const u16x4 xa = *(const u16x4*)(rp + ch), xg = *(const u16x4*)(rp + DFF + ch);
            const f32x4 wa = *(const f32x4*)(wc_ + ch), wg = *(const f32x4*)(wc_ + DFF + ch);
#pragma unroll
            for (int j = 0; j < 4; ++j) { va[j] += wa[j] * bf2f(xa[j]); vg[j] += wg[j] * bf2f(xg[j]); }
        }
        if (hn) {
            const u16x4 xa = *(const u16x4*)(rn + ch), xg = *(const u16x4*)(rn + DFF + ch);
            const f32x4 wa = *(const f32x4*)(wc_ + 2 * DFF2 + ch), wg = *(const f32x4*)(wc_ + 2 * DFF2 + DFF + ch);
#pragma unroll
            for (int j = 0; j < 4; ++j) { va[j] += wa[j] * bf2f(xa[j]); vg[j] += wg[j] * bf2f(xg[j]); }
        }
        f32x4 o;
#pragma unroll
        for (int j = 0; j < 4; ++j) o[j] = siluf_(vg[j]) * va[j];
        store_bf4(act + (size_t)R * DFF + ch, o);
    }
    asm volatile("s_waitcnt vmcnt(0)" ::: "memory");
    __syncthreads();
}

DEV bf16x8 frag4(unsigned a, unsigned b, unsigned c, unsigned d) { u32x4 v; v[0] = a; v[1] = b; v[2] = c; v[3] = d; return __builtin_bit_cast(bf16x8, v); }
DEV bf16x8 ld16(const bf16_t* p) { return *(const bf16x8*)p; }
DEV u32x2 ld8(const bf16_t* p) { return *(const u32x2*)p; }
#define MFMA16(a, b, c) __builtin_amdgcn_mfma_f32_16x16x32_bf16(a, b, c, 0, 0, 0)

DEV void scan_ret_mfma(KP p, int l, int it, unsigned char* lds, unsigned* qctr, volatile LAS3 unsigned* nxt) {
    const int tid0 = otid();
    int s, head, dir, sl;
    if (it < 64) { s = 16 + (it >> 4); head = (it >> 2) & 3; dir = (it >> 1) & 1; sl = it & 1; }
    else { const int k = it - 64; s = k >> 4; head = (k >> 2) & 3; dir = (k >> 1) & 1; sl = k & 1; }
    const int row0 = seq_row0(s), T = seq_len(s);
    bf16_t* Qs = (bf16_t*)lds;
    bf16_t* Ks = Qs + 64 * 264;
    bf16_t* Kt = Ks + 64 * 264;
    bf16_t* Vt = Kt + 256 * 72;
    bf16_t* Ps = Vt + 256 * 72;
    float* gp = (float*)(Ps + 64 * 72);
    const bf16_t* qb = (const bf16_t*)(p->ws + OFF_QB);
    const bf16_t* kb = (const bf16_t*)(p->ws + OFF_KB);
    const bf16_t* vb = (const bf16_t*)(p->ws + OFF_VB);
    bf16_t* oo = (bf16_t*)(p->ws + (dir ? OFF_OBB : OFF_OBF));
    const float gamma = 1.f - exp2f(-(5.f + (dir ? 0.5f : 0.f)) - (float)head);
    const float lg2 = log2f(gamma);
    bf16x8 pq[4], pk[4], pv[4];
#define RET_ISSUE_QK(cc) do { const int tq_ = tid >> 5, c8_ = tid & 31; _Pragma("unroll") for (int i = 0; i < 4; ++i) { const int j = 4 * tq_ + i, tok = dir ? (T - 1 - ((cc) + j)) : ((cc) + j); \
        const size_t g = (size_t)(row0 + tok) * 1024 + head * 256 + c8_ * 8; pq[i] = *(const bf16x8*)(qb + g); pk[i] = *(const bf16x8*)(kb + g); } } while (0)
#define RET_ISSUE_V(cc) do { const int tq_ = tid >> 5, c8_ = tid & 31; _Pragma("unroll") for (int i = 0; i < 4; ++i) { const int j = 4 * tq_ + i, tok = dir ? (T - 1 - ((cc) + j)) : ((cc) + j); \
        pv[i] = *(const bf16x8*)(vb + (size_t)(row0 + tok) * 2048 + head * 512 + sl * 256 + 8 * c8_); } } while (0)
    { const int tid = tid0; RET_ISSUE_QK(0); RET_ISSUE_V(0); }
    if (tid0 == 448) *nxt = xb_add(qctr, 1u);
    __syncthreads();
    if (tid0 < 65) gp[tid0] = exp2f((float)tid0 * lg2);
    f32x4 S[16][2];
    {
        const int w = tid0 >> 6, fr = tid0 & 15, fq = (tid0 >> 4) & 3;
        if (s >= 16) {
            const float* st = p->state_ret + ((((size_t)(s - 16) * 2 + l) * 2 + dir) * 4 + head) * 256 * 512 + sl * 256 + 32 * w + 8 * (fr >> 2) + (fr & 3);
#pragma unroll
            for (int dt = 0; dt < 16; ++dt)
#pragma unroll
                for (int dvt = 0; dvt < 2; ++dvt)
#pragma unroll
                    for (int jj = 0; jj < 4; ++jj) S[dt][dvt][jj] = st[(size_t)(16 * dt + 4 * fq + jj) * 512 + 4 * dvt];
        } else {
#pragma unroll
            for (int dt = 0; dt < 16; ++dt) { S[dt][0] = (f32x4){0.f, 0.f, 0.f, 0.f}; S[dt][1] = (f32x4){0.f, 0.f, 0.f, 0.f}; }
        }
    }
    for (int c0 = 0; c0 < T; c0 += 64) {
        int tid = tid0; asm volatile("" : "+v"(tid));
        const int w = tid >> 6, lane = tid & 63, fr = lane & 15, fq = lane >> 4, tq = tid >> 5, c8 = tid & 31;
        __syncthreads();
        {
            const float g0 = gp[63 - 4 * tq], g1 = gp[62 - 4 * tq], g2 = gp[61 - 4 * tq], g3 = gp[60 - 4 * tq];
#pragma unroll
            for (int i = 0; i < 4; ++i) { *(bf16x8*)(Qs + (4 * tq + i) * 264 + c8 * 8) = pq[i]; *(bf16x8*)(Ks + (4 * tq + i) * 264 + c8 * 8) = pk[i]; }
            const int kpos = 8 * ((tq >> 1) ^ (c8 & 7)) + 4 * (tq & 1);
#pragma unroll
            for (int c = 0; c < 8; ++c) {
                u32x2 o;
                o[0] = pk2(bf2f((bf16_t)pk[0][c]) * g0, bf2f((bf16_t)pk[1][c]) * g1);
                o[1] = pk2(bf2f((bf16_t)pk[2][c]) * g2, bf2f((bf16_t)pk[3][c]) * g3);
                *(u32x2*)(Kt + (c8 * 8 + c) * 72 + kpos) = o;
                if (c & 1) __builtin_amdgcn_sched_barrier(0);
            }
#pragma unroll
            for (int c = 0; c < 8; ++c) {
                u32x2 o;
                o[0] = (unsigned)(bf16_t)pv[0][c] | ((unsigned)(bf16_t)pv[1][c] << 16);
                o[1] = (unsigned)(bf16_t)pv[2][c] | ((unsigned)(bf16_t)pv[3][c] << 16);
                *(u32x2*)(Vt + (c8 * 8 + c) * 72 + kpos) = o;
                if (c & 1) __builtin_amdgcn_sched_barrier(0);
            }
        }
        __syncthreads();
#pragma unroll
        for (int h = 0; h < 2; ++h) {
            const int idx = w + 8 * h, ti = idx >> 2, tj = idx & 3;
            f32x4 acc = (f32x4){0.f, 0.f, 0.f, 0.f};
            if (tj <= ti) {
#pragma unroll
                for (int ks = 0; ks < 8; ++ks)
                    acc = MFMA16(ld16(Ks + (16 * tj + fr) * 264 + 32 * ks + 8 * fq), ld16(Qs + (16 * ti + fr) * 264 + 32 * ks + 8 * fq), acc);
                const int i = 16 * ti + fr, j0 = 16 * tj + 4 * fq;
#pragma unroll
                for (int jj = 0; jj < 4; ++jj) { const int d = i - (j0 + jj); acc[jj] = d >= 0 ? acc[jj] * gp[d >= 0 ? d : 0] : 0.f; }
            }
            u32x2 o; o[0] = pk2(acc[0], acc[1]); o[1] = pk2(acc[2], acc[3]);
            *(u32x2*)(Ps + (16 * ti + fr) * 72 + 16 * tj + 4 * fq) = o;
        }
        __syncthreads();
        const int dv0 = 32 * w + 8 * (fr >> 2) + (fr & 3), dv1 = dv0 + 4;
        const int vsw0 = (dv0 >> 3) & 7, vsw1 = (dv1 >> 3) & 7;
        const bf16_t* vrow0 = Vt + dv0 * 72; const bf16_t* vrow1 = Vt + dv1 * 72;
        const bf16x8 vf00 = ld16(vrow0 + 8 * (fq ^ vsw0)), vf01 = ld16(vrow0 + 8 * ((4 + fq) ^ vsw0));
        const bf16x8 vf10 = ld16(vrow1 + 8 * (fq ^ vsw1)), vf11 = ld16(vrow1 + 8 * ((4 + fq) ^ vsw1));
        {
            f32x4 o[4][2];
#pragma unroll
            for (int tt = 0; tt < 4; ++tt) { o[tt][0] = (f32x4){0.f, 0.f, 0.f, 0.f}; o[tt][1] = (f32x4){0.f, 0.f, 0.f, 0.f}; }
            const bf16_t* qbase = Qs + fr * 264 + 4 * fq;
#pragma unroll
            for (int q = 0; q < 8; ++q) {
                const bf16x8 sf0 = frag4(pk2(S[2 * q][0][0], S[2 * q][0][1]), pk2(S[2 * q][0][2], S[2 * q][0][3]), pk2(S[2 * q + 1][0][0], S[2 * q + 1][0][1]), pk2(S[2 * q + 1][0][2], S[2 * q + 1][0][3]));
                const bf16x8 sf1 = frag4(pk2(S[2 * q][1][0], S[2 * q][1][1]), pk2(S[2 * q][1][2], S[2 * q][1][3]), pk2(S[2 * q + 1][1][0], S[2 * q + 1][1][1]), pk2(S[2 * q + 1][1][2], S[2 * q + 1][1][3]));
#pragma unroll
                for (int tt = 0; tt < 4; ++tt) {
                    const u32x2 b0 = ld8(qbase + 16 * tt * 264 + 32 * q), b1 = ld8(qbase + 16 * tt * 264 + 32 * q + 16);
                    const bf16x8 bq = frag4(b0[0], b0[1], b1[0], b1[1]);
                    o[tt][0] = MFMA16(sf0, bq, o[tt][0]);
                    o[tt][1] = MFMA16(sf1, bq, o[tt][1]);
                }
                __builtin_amdgcn_sched_barrier(0);
            }
            const bf16_t* pbase = Ps + fr * 72 + 8 * fq;
            const float* gbase = gp + fr + 1;
            const int i0 = c0 + fr;
#pragma unroll
            for (int tt = 0; tt < 4; ++tt) {
                const float sc = gbase[16 * tt];
                o[tt][0] = o[tt][0] * sc; o[tt][1] = o[tt][1] * sc;
                const bf16x8 p0 = ld16(pbase + 16 * tt * 72), p1 = ld16(pbase + 16 * tt * 72 + 32);
                o[tt][0] = MFMA16(vf00, p0, o[tt][0]); o[tt][0] = MFMA16(vf01, p1, o[tt][0]);
                o[tt][1] = MFMA16(vf10, p0, o[tt][1]); o[tt][1] = MFMA16(vf11, p1, o[tt][1]);
                const int pos = i0 + 16 * tt, tok = dir ? (T - 1 - pos) : pos;
                bf16_t* op = oo + (size_t)(row0 + tok) * 2048 + head * 512 + sl * 256 + 32 * w + 8 * fq;
                u32x4 ov; ov[0] = pk2(o[tt][0][0], o[tt][0][1]); ov[1] = pk2(o[tt][0][2], o[tt][0][3]); ov[2] = pk2(o[tt][1][0], o[tt][1][1]); ov[3] = pk2(o[tt][1][2], o[tt][1][3]);
                *(u32x4*)op = ov;
                __builtin_amdgcn_sched_barrier(0);
            }
        }
        __builtin_amdgcn_sched_barrier(0);
        if (c0 + 64 < T) RET_ISSUE_QK(c0 + 64);
        __builtin_amdgcn_sched_barrier(0);
        {
            const float g64 = gp[64];
            const bf16_t* kbase = Kt + fr * 72;
            const int kswb = (fr >> 3) & 1;
#pragma unroll
            for (int dt = 0; dt < 16; ++dt) {
                const int ksw = (2 * dt + kswb) & 7;
                const bf16x8 k0 = ld16(kbase + 16 * dt * 72 + 8 * (fq ^ ksw)), k1 = ld16(kbase + 16 * dt * 72 + 8 * ((4 + fq) ^ ksw));
                S[dt][0] = S[dt][0] * g64; S[dt][1] = S[dt][1] * g64;
                S[dt][0] = MFMA16(k0, vf00, S[dt][0]); S[dt][0] = MFMA16(k1, vf01, S[dt][0]);
                S[dt][1] = MFMA16(k0, vf10, S[dt][1]); S[dt][1] = MFMA16(k1, vf11, S[dt][1]);
                if (dt & 1) __builtin_amdgcn_sched_barrier(0);
            }
        }
        if (c0 + 64 < T) RET_ISSUE_V(c0 + 64);
    }
#undef RET_ISSUE_QK
#undef RET_ISSUE_V
    if (s < 16) {
        const int w = tid0 >> 6, fr = tid0 & 15, fq = (tid0 >> 4) & 3;
        float* st = p->out + OUT_SR + ((((size_t)s * 2 + l) * 2 + dir) * 4 + head) * 256 * 512 + sl * 256 + 32 * w + 8 * (fr >> 2) + (fr & 3);
#pragma unroll
        for (int dt = 0; dt < 16; ++dt)
#pragma unroll
            for (int dvt = 0; dvt < 2; ++dvt)
#pragma unroll
                for (int jj = 0; jj < 4; ++jj) st[(size_t)(16 * dt + 4 * fq + jj) * 512 + 4 * dvt] = S[dt][dvt][jj];
    }
}

DEV void scan_hgrn_mfma(KP p, int l, int it, unsigned char* lds, unsigned* qctr, volatile LAS3 unsigned* nxt) {
    const int tid = otid(), w = tid >> 6, lane = tid & 63, fr = lane & 15, fq = lane >> 4;
    int s, head, dir;
    if (it < 64) { s = 16 + (it >> 4); head = (it >> 1) & 7; dir = it & 1; }
    else { const int k = it - 64; s = k >> 4; head = (k >> 1) & 7; dir = k & 1; }
    const int row0 = seq_row0(s), T = seq_len(s);
    bf16_t* Qd = (bf16_t*)lds;
    bf16_t* Kn = Qd + 4 * 16 * 136;
    bf16_t* Kdt = Kn + 4 * 16 * 136;
    bf16_t* Vt = Kdt + 4 * 128 * 24;
    float* ae = (float*)(Vt + 4 * 128 * 24);
    const float* lfp = (const float*)(p->ws + (dir ? OFF_LFB : OFF_LFF));
    const bf16_t* qa = (const bf16_t*)(p->ws + OFF_QA);
    const bf16_t* ia = (const bf16_t*)(p->ws + OFF_IA);
    bf16_t* oo = (bf16_t*)(p->ws + (dir ? OFF_OAB : OFF_OAF));
    const int d = tid & 127, sub = tid >> 7;
    float plf[16]; bf16_t pqv[16], pvv[16];
#define HG_ISSUE(cc) do { _Pragma("unroll") for (int i = 0; i < 16; ++i) { const int pos = (cc) + 16 * sub + i, tok = dir ? (T - 1 - pos) : pos; \
        const size_t g = (size_t)(row0 + tok) * 1024 + head * 128 + d; plf[i] = lfp[g]; pqv[i] = qa[g]; pvv[i] = ia[g]; } } while (0)
    HG_ISSUE(0);
    if (tid == 448) *nxt = xb_add(qctr, 1u);
    f32x4 S[8];
    if (s >= 16) {
        const float* st = p->state_hgrn + ((((size_t)(s - 16) * 2 + l) * 2 + dir) * 8 + head) * 128 * 128 + 16 * w + fr;
#pragma unroll
        for (int dt = 0; dt < 8; ++dt)
#pragma unroll
            for (int jj = 0; jj < 4; ++jj) S[dt][jj] = st[(size_t)(16 * dt + 4 * fq + jj) * 128];
    } else {
#pragma unroll
        for (int dt = 0; dt < 8; ++dt) S[dt] = (f32x4){0.f, 0.f, 0.f, 0.f};
    }
    for (int c0 = 0; c0 < T; c0 += 64) {
        __syncthreads();
        {
            float cum = 0.f;
            float kn[16];
            unsigned vpk[8], kpk[8];
#pragma unroll
            for (int i = 0; i < 16; ++i) {
                const float lf = plf[i] * 1.4426950408889634f;
                cum += lf;
                const float k = 1.f - __builtin_amdgcn_exp2f(lf), q = bf2f(pqv[i]);
                const unsigned v = pvv[i];
                const float ec = __builtin_amdgcn_exp2f(fmaxf(cum, -100.f)), en = __builtin_amdgcn_rcpf(ec);
                Qd[(sub * 16 + i) * 136 + d] = f2bf(q * ec);
                kn[i] = k * en;
                Kn[(sub * 16 + i) * 136 + d] = f2bf(kn[i]);
                if (i & 1) vpk[i >> 1] |= v << 16; else vpk[i >> 1] = v;
            }
            const float aend = __builtin_amdgcn_exp2f(fmaxf(cum, -100.f));
            ae[sub * 128 + d] = aend;
#pragma unroll
            for (int i = 0; i < 8; ++i) kpk[i] = pk2(kn[2 * i] * aend, kn[2 * i + 1] * aend);
            u32x4 t0, t1;
            t0[0] = kpk[0]; t0[1] = kpk[1]; t0[2] = kpk[2]; t0[3] = kpk[3]; t1[0] = kpk[4]; t1[1] = kpk[5]; t1[2] = kpk[6]; t1[3] = kpk[7];
            *(u32x4*)(Kdt + (sub * 128 + d) * 24) = t0; *(u32x4*)(Kdt + (sub * 128 + d) * 24 + 8) = t1;
            t0[0] = vpk[0]; t0[1] = vpk[1]; t0[2] = vpk[2]; t0[3] = vpk[3]; t1[0] = vpk[4]; t1[1] = vpk[5]; t1[2] = vpk[6]; t1[3] = vpk[7];
            *(u32x4*)(Vt + (sub * 128 + d) * 24) = t0; *(u32x4*)(Vt + (sub * 128 + d) * 24 + 8) = t1;
        }
        if (c0 + 64 < T) HG_ISSUE(c0 + 64);
        __syncthreads();
#pragma unroll
        for (int sc = 0; sc < 4; ++sc) {
            const bf16_t* qd = Qd + sc * 16 * 136; const bf16_t* knp = Kn + sc * 16 * 136;
            const bf16_t* kdt = Kdt + sc * 128 * 24; const bf16_t* vt = Vt + sc * 128 * 24;
            f32x4 pa = (f32x4){0.f, 0.f, 0.f, 0.f};
#pragma unroll
            for (int ks = 0; ks < 4; ++ks) pa = MFMA16(ld16(knp + fr * 136 + 32 * ks + 8 * fq), ld16(qd + fr * 136 + 32 * ks + 8 * fq), pa);
#pragma unroll
            for (int jj = 0; jj < 4; ++jj) pa[jj] = (4 * fq + jj <= fr) ? pa[jj] : 0.f;
            const bf16x8 pb = frag4(pk2(pa[0], pa[1]), pk2(pa[2], pa[3]), 0u, 0u);
            f32x4 o = (f32x4){0.f, 0.f, 0.f, 0.f};
#pragma unroll
            for (int q = 0; q < 4; ++q) {
                const bf16x8 sf = frag4(pk2(S[2 * q][0], S[2 * q][1]), pk2(S[2 * q][2], S[2 * q][3]), pk2(S[2 * q + 1][0], S[2 * q + 1][1]), pk2(S[2 * q + 1][2], S[2 * q + 1][3]));
                const u32x2 b0 = ld8(qd + fr * 136 + 32 * q + 4 * fq), b1 = ld8(qd + fr * 136 + 32 * q + 16 + 4 * fq);
                o = MFMA16(sf, frag4(b0[0], b0[1], b1[0], b1[1]), o);
            }
            {
                const u32x2 va = ld8(vt + (16 * w + fr) * 24 + 4 * fq);
                o = MFMA16(frag4(va[0], va[1], 0u, 0u), pb, o);
            }
            {
                const int pos = c0 + 16 * sc + fr, tok = dir ? (T - 1 - pos) : pos;
                u32x2 ov; ov[0] = pk2(o[0], o[1]); ov[1] = pk2(o[2], o[3]);
                *(u32x2*)(oo + (size_t)(row0 + tok) * 1024 + head * 128 + 16 * w + 4 * fq) = ov;
            }
            bf16x8 vf = frag4(0u, 0u, 0u, 0u);
            if (fq < 2) vf = ld16(vt + (16 * w + fr) * 24 + 8 * fq);
#pragma unroll
            for (int dt = 0; dt < 8; ++dt) {
                const f32x4 a4 = *(const f32x4*)(ae + sc * 128 + 16 * dt + 4 * fq);
                S[dt] = S[dt] * a4;
                bf16x8 kf = frag4(0u, 0u, 0u, 0u);
                if (fq < 2) kf = ld16(kdt + (16 * dt + fr) * 24 + 8 * fq);
                S[dt] = MFMA16(kf, vf, S[dt]);
            }
        }
    }
#undef HG_ISSUE
    if (s < 16) {
        float* st = p->out + OUT_SH + ((((size_t)s * 2 + l) * 2 + dir) * 8 + head) * 128 * 128 + 16 * w + fr;
#pragma unroll
        for (int dt = 0; dt < 8; ++dt)
#pragma unroll
            for (int jj = 0; jj < 4; ++jj) st[(size_t)(16 * dt + 4 * fq + jj) * 128] = S[dt][jj];
    }
}

DEV void phase_scan(KP p, int l, float* lds, int qi) {
    p = fresh(p);
    unsigned* qctr = (unsigned*)(p->ws + OFF_BAR) + 3520 + 64 * qi;
    volatile LAS3 unsigned* bcw = (volatile LAS3 unsigned*)((LAS3 unsigned char*)lds + LDS_BYTES - 8);
    __syncthreads();
    if (otid() == 0) bcw[0] = xb_add(qctr, 1u);
    int par = 0;
    for (;;) {
        __syncthreads();
        const int it = (int)bcw[par];
        if (it >= 1280) break;
        volatile LAS3 unsigned* nxt = bcw + (par ^ 1);
        if (it < 64) scan_ret_mfma(p, l, it, (unsigned char*)lds, qctr, nxt);
        else if (it < 128) scan_hgrn_mfma(p, l, it - 64, (unsigned char*)lds, qctr, nxt);
        else if (it < 768) {
            if (otid() == 448) *nxt = xb_add(qctr, 1u);
            unsigned char* ws = p->ws;
            EpiInProj E{ws, l};
            Prog S = prog_plain((const bf16_t*)(ws + OFF_H), (const bf16_t*)(ws + OFF_WIN), 1024, 1024, 1024);
            S.pnmap = 2;
            gemm_one(S, 32, 20, it - 128, E, (bf16_t*)lds);
        }
        else if (it < 1024) scan_ret_mfma(p, l, it - 768 + 64, (unsigned char*)lds, qctr, nxt);
        else scan_hgrn_mfma(p, l, it - 1024 + 64, (unsigned char*)lds, qctr, nxt);
        par ^= 1;
    }
    __syncthreads();
}

DEV void phase_combine(KP p) {
    p = fresh(p);
    const int tid = otid(), wid = tid >> 6, lane = tid & 63;
    const bf16_t* oaf = (const bf16_t*)(p->ws + OFF_OAF); const bf16_t* oab = (const bf16_t*)(p->ws + OFF_OAB);
    const bf16_t* obf = (const bf16_t*)(p->ws + OFF_OBF); const bf16_t* obb = (const bf16_t*)(p->ws + OFF_OBB);
    const bf16_t* ga = (const bf16_t*)(p->ws + OFF_GA); const bf16_t* gb = (const bf16_t*)(p->ws + OFF_GB);
    bf16_t* oa = (bf16_t*)(p->ws + OFF_OA); bf16_t* ob = (bf16_t*)(p->ws + OFF_OB);
    const int stride = gridDim.x * 8;
    for (int row0 = blockIdx.x * 8 + wid; row0 < NTOK; row0 += 2 * stride) {
        u16x8 af[2][2], ab[2][2], ag[2][2], bf[2][4], bb[2][4], bg[2][4];
#pragma unroll
        for (int r = 0; r < 2; ++r) {
            const int row = row0 + r * stride;
            if (row < NTOK) {
                const size_t ba = (size_t)row * 1024 + lane * 16, bbs = (size_t)row * 2048 + lane * 32;
#pragma unroll
                for (int h8 = 0; h8 < 2; ++h8) { af[r][h8] = *(const u16x8*)(oaf + ba + h8 * 8); ab[r][h8] = *(const u16x8*)(oab + ba + h8 * 8); ag[r][h8] = *(const u16x8*)(ga + ba + h8 * 8); }
#pragma unroll
                for (int h8 = 0; h8 < 4; ++h8) { bf[r][h8] = *(const u16x8*)(obf + bbs + h8 * 8); bb[r][h8] = *(const u16x8*)(obb + bbs + h8 * 8); bg[r][h8] = *(const u16x8*)(gb + bbs + h8 * 8); }
            }
        }
#pragma unroll
        for (int r = 0; r < 2; ++r) {
            const int row = row0 + r * stride;
            if (row < NTOK) {
                {
                    const size_t base = (size_t)row * 1024 + lane * 16;
                    float o[16]; float ss = 0.f;
#pragma unroll
                    for (int h8 = 0; h8 < 2; ++h8)
#pragma unroll
                        for (int i = 0; i < 8; ++i) { o[h8 * 8 + i] = bf2f(af[r][h8][i]) + bf2f(ab[r][h8][i]); ss += o[h8 * 8 + i] * o[h8 * 8 + i]; }
                    ss += shfl_xor_l(ss, 1, lane); ss += shfl_xor_l(ss, 2, lane); ss += shfl_xor_l(ss, 4, lane);
                    const float rstd = rsqrtf(ss * (1.f / 128.f) + EPS);
#pragma unroll
                    for (int h8 = 0; h8 < 2; ++h8) {
                        u32x4 rr;
#pragma unroll
                        for (int i = 0; i < 4; ++i) rr[i] = pk2(o[h8 * 8 + 2 * i] * rstd * siluf_(bf2f(ag[r][h8][2 * i])), o[h8 * 8 + 2 * i + 1] * rstd * siluf_(bf2f(ag[r][h8][2 * i + 1])));
                        *(u32x4*)(oa + base + h8 * 8) = rr;
                    }
                }
                {
                    const size_t base = (size_t)row * 2048 + lane * 32;
                    float o[32]; float ss = 0.f;
#pragma unroll
                    for (int h8 = 0; h8 < 4; ++h8)
#pragma unroll
                        for (int i = 0; i < 8; ++i) { o[h8 * 8 + i] = bf2f(bf[r][h8][i]) + bf2f(bb[r][h8][i]); ss += o[h8 * 8 + i] * o[h8 * 8 + i]; }
                    ss += shfl_xor_l(ss, 1, lane); ss += shfl_xor_l(ss, 2, lane); ss += shfl_xor_l(ss, 4, lane); ss += shfl_xor_l(ss, 8, lane);
                    const float rstd = rsqrtf(ss * (1.f / 512.f) + EPS);
#pragma unroll
                    for (int h8 = 0; h8 < 4; ++h8) {
                        u32x4 rr;
#pragma unroll
                        for (int i = 0; i < 4; ++i) rr[i] = pk2(o[h8 * 8 + 2 * i] * rstd * siluf_(bf2f(bg[r][h8][2 * i])), o[h8 * 8 + 2 * i + 1] * rstd * siluf_(bf2f(bg[r][h8][2 * i + 1])));
                        *(u32x4*)(ob + base + h8 * 8) = rr;
                    }
                }
            }
        }
    }
}

DEV void phase_convact(KP p, int l) {
    p = fresh(p);
    const bf16_t* u = (const bf16_t*)(p->ws + OFF_U);
    bf16_t* act = (bf16_t*)(p->ws + OFF_ACT);
    const float* wc = p->w_conv + (size_t)l * 3 * DFF2;
    const float* bc = p->b_conv + (size_t)l * DFF2;
    const int total = NTOK * (DFF / 8);
    for (int i = blockIdx.x * NTHR + otid(); i < total; i += gridDim.x * NTHR) {
        const int row = i / (DFF / 8), f = (i % (DFF / 8)) * 8;
        int t, T;
        if (row < NCTX) { t = row & 255; T = 256; } else { t = (row - NCTX) & 1023; T = 1024; }
        float ca[8], cgv[8];
#pragma unroll
        for (int k = 0; k < 8; ++k) { ca[k] = bc[f + k]; cgv[k] = bc[DFF + f + k]; }
#pragma unroll
        for (int dt = -1; dt <= 1; ++dt) {
            if (t + dt < 0 || t + dt >= T) continue;
            const bf16_t* ur = u + (size_t)(row + dt) * DFF2;
            const u16x8 ua = *(const u16x8*)(ur + f), ug = *(const u16x8*)(ur + DFF + f);
            const float* w = wc + (dt + 1) * DFF2;
#pragma unroll
            for (int k = 0; k < 8; ++k) { ca[k] += bf2f(ua[k]) * w[f + k]; cgv[k] += bf2f(ug[k]) * w[DFF + f + k]; }
        }
        u16x8 r;
#pragma unroll
        for (int k = 0; k < 8; ++k) r[k] = f2bf(siluf_(cgv[k]) * ca[k]);
        *(u16x8*)(act + (size_t)row * DFF + f) = r;
    }
}

#define XB_TMO      128
#define XB_XCNT(j)  (256  + 64 * (j))
#define XB_XSUB(j)  (1280 + 64 * (j))
#define XB_XGEN(j)  (2304 + 64 * (j))
#define XB_TOP      3328
#define XB_TOPGEN   3392
#define XCD_BAR_WORDS 3456
#define XB_SPIN_CAP (1u << 18)
DEV unsigned xb_ld(unsigned* p) { return __hip_atomic_load(p, __ATOMIC_RELAXED, __HIP_MEMORY_SCOPE_AGENT); }
DEV unsigned xb_xcc_id() { return (unsigned)__builtin_amdgcn_s_getreg((3 << 11) | 20) & 0xFu; }
#define XB_SPIN(cond, bar) do { unsigned _sp = 0; while (cond) { __builtin_amdgcn_s_sleep(1); \
    if ((++_sp & 255u) == 0u) { if (xb_ld(&(bar)[XB_TMO])) break; if (_sp > XB_SPIN_CAP) { (void)xb_add(&(bar)[XB_TMO], 1u); break; } } } } while (0)
struct XcdBarrier { KP kp; volatile LAS3 unsigned* st; };
DEV XcdBarrier xcd_barrier_post(KP kp, volatile LAS3 unsigned* st) {
    XcdBarrier b; b.kp = kp; b.st = st;
    unsigned* bar = (unsigned*)(kp->ws + OFF_BAR);
    if (threadIdx.x == 0) (void)xb_add(&bar[XB_XCNT(xb_xcc_id())], 1u);
    return b;
}
DEV void xcd_barrier_complete(unsigned* bar, unsigned x, unsigned& nloc, unsigned& nx) {
    const unsigned G = gridDim.x * gridDim.y * gridDim.z;
    unsigned sum, cnt, mine, sp = 0u;
    for (;;) {
        sum = 0u; cnt = 0u; mine = 0u;
#pragma unroll
        for (unsigned j = 0; j < 16; ++j) { const unsigned c = xb_ld(&bar[XB_XCNT(j)]); sum += c; cnt += (c > 0u) ? 1u : 0u; mine = (j == x) ? c : mine; }
        if (sum == G) break;
        __builtin_amdgcn_s_sleep(1);
        if ((++sp & 255u) == 0u) { if (xb_ld(&bar[XB_TMO])) break; if (sp > XB_SPIN_CAP) { (void)xb_add(&bar[XB_TMO], 1u); break; } }
    }
    nloc = mine > 0u ? mine : 1u; nx = cnt > 0u ? cnt : 1u;
}
DEV void xcd_barrier(const XcdBarrier& b) {
    asm volatile("s_waitcnt vmcnt(0)" ::: "memory");
    __syncthreads();
    if (threadIdx.x == 0) {
        unsigned* bar = (unsigned*)(fresh(b.kp)->ws + OFF_BAR);
        const unsigned bx = xb_xcc_id();
        __builtin_amdgcn_s_waitcnt(0);
        unsigned nloc = b.st[0], nx = b.st[1];
        if (nloc == 0u) { xcd_barrier_complete(bar, bx, nloc, nx); b.st[0] = nloc; b.st[1] = nx; }
        const unsigned old = xb_add(&bar[XB_XSUB(bx)], 1u);
        const unsigned gen = old / nloc;
        if (old + 1u == (gen + 1u) * nloc) {
            __builtin_amdgcn_fence(__ATOMIC_RELEASE, "agent");
            asm volatile("s_waitcnt vmcnt(0)" ::: "memory");
            const unsigned og = xb_add(&bar[XB_TOP], 1u);
            const unsigned tg = og / nx;
            if (og + 1u == (tg + 1u) * nx) xb_add(&bar[XB_TOPGEN], 1u);
            else XB_SPIN(xb_ld(&bar[XB_TOPGEN]) == tg, bar);
            __builtin_amdgcn_fence(__ATOMIC_ACQUIRE, "agent");
            xb_add(&bar[XB_XGEN(bx)], 1u);
            asm volatile("s_waitcnt vmcnt(0)" ::: "memory");
        } else {
            XB_SPIN(xb_ld(&bar[XB_XGEN(bx)]) == gen, bar);
            __builtin_amdgcn_fence(__ATOMIC_ACQUIRE, "agent");
            asm volatile("s_waitcnt vmcnt(0)" ::: "memory");
        }
    }
    __syncthreads();
}

#ifndef SKIP_MODS
#define RUN_MODS(x) x
#else
#define RUN_MODS(x)
#endif
#ifndef SKIP_CONV
#define RUN_CONV(x) x
#else
#define RUN_CONV(x)
#endif
#ifndef SKIP_NORM
#define RUN_NORM(x) x
#else
#define RUN_NORM(x)
#endif
#if defined(DUP_GEMM)
#define RUN_GEMM(x) x x
#elif !defined(SKIP_GEMM)
#define RUN_GEMM(x) x
#else
#define RUN_GEMM(x)
#endif
#if defined(DUP_SCAN)
#define RUN_SCAN(x) x x
#elif !defined(SKIP_SCAN)
#define RUN_SCAN(x) x
#else
#define RUN_SCAN(x)
#endif
#ifndef SKIP_COMB
#define RUN_COMB(x) x
#else
#define RUN_COMB(x)
#endif
#ifndef SKIP_ACT
#define RUN_ACT(x) x
#else
#define RUN_ACT(x)
#endif
__global__ void __launch_bounds__(NTHR) fwd_megakernel(Params p_unused) {
    cg::grid_group grid = cg::this_grid();
    extern __shared__ __attribute__((aligned(16))) unsigned char smem[];
    float* ldsf = (float*)smem;
    bf16_t* ldsh = (bf16_t*)smem;
    KP kp = (KP)__builtin_amdgcn_kernarg_segment_ptr();
    volatile LAS3 unsigned* xst = (volatile LAS3 unsigned*)((LAS3 unsigned char*)smem + LDS_BYTES - 16);
    if (threadIdx.x == 0) { xst[0] = 0u; xst[1] = 0u; }
    __syncthreads();
    const XcdBarrier xb = xcd_barrier_post(kp, xst);

    RUN_MODS(phase_mods(kp, ldsf);)
    RUN_CONV(phase_convert(kp, 0, ldsf);)
    if (kp->ws == nullptr) grid.sync();
    xcd_barrier(xb);
#pragma unroll 1
    for (int l = 0; l < 2; ++l) {
        if (l == 0) { RUN_NORM(phase_norm(kp, 0, 0, 0, 0, 1, 0);) }
        else { RUN_CONV(phase_convert(kp, 1, ldsf);) RUN_NORM(phase_norm(kp, 1, 1, 1,   0 * 8 + 5, 1, 0);) }
        xcd_barrier(xb);
        {
            unsigned char* ws = fresh(kp)->ws;
            EpiInProj E{ws, l};
            Prog S = prog_plain((const bf16_t*)(ws + OFF_H), (const bf16_t*)(ws + OFF_WIN), 1024, 1024, 1024);
            S.pnmap = 1;
            RUN_GEMM(gemm_run(S, 32, 32, E, ldsh);)
        }
        xcd_barrier(xb);
        RUN_SCAN(phase_scan(kp, l, ldsf, l);)
#ifdef DUP_SCAN2
        phase_scan(kp, l, ldsf, l + 2);
#endif
        xcd_barrier(xb);
        RUN_COMB(phase_combine(kp);)
        xcd_barrier(xb);
        {
            unsigned char* ws = fresh(kp)->ws;
            Prog S = prog_plain((const bf16_t*)(ws + OFF_OA), (const bf16_t*)(ws + OFF_PA), 1024, 1024, 1024);
            S.A1 = (const bf16_t*)(ws + OFF_OB); S.B1 = (const bf16_t*)(ws + OFF_PB); S.lda1 = 2048; S.ldb1 = 2048; S.K1a = 512; S.K1b = 1536; S.mode = 1; S.ks = 2;
            EpiMerged E{ws};
            RUN_GEMM(gemm_run(S, 32, 4, E, ldsh);)
        }
        xcd_barrier(xb);
        {
            unsigned char* ws = fresh(kp)->ws;
            Prog S = prog_plain((const bf16_t*)(ws + OFF_MERGED), (const bf16_t*)(ws + OFF_WOUT), 1024, 1024, 1024);
            S.A1 = (const bf16_t*)(ws + OFF_MERGED) + (size_t)NTOK * 1024; S.ks = 2; S.bsame = 1;
            EpiBf E{(bf16_t*)(ws + OFF_P), (bf16_t*)(ws + OFF_P1), 1024};
            RUN_GEMM(gemm_run(S, 32, 4, E, ldsh);)
        }
        xcd_barrier(xb);
        RUN_NORM(phase_norm(kp, 1, 2 + l, l, l * 8 + 2, 4, 3);)
        xcd_barrier(xb);
        {
            KP pp = fresh(kp);
            unsigned char* ws = pp->ws;
            EpiUpConv E{ws, pp->w_conv + (size_t)l * 3 * DFF2, pp->b_conv + (size_t)l * DFF2};
            RUN_GEMM(gemm_run(prog_plain((const bf16_t*)(ws + OFF_H), (const bf16_t*)(ws + OFF_WUP), 1024, 1024, 1024), 32, 22, E, ldsh);)
        }
        xcd_barrier(xb);
        {
            KP pp = fresh(kp);
            unsigned char* ws = pp->ws;
            Prog S = prog_plain((const bf16_t*)(ws + OFF_ACT), (const bf16_t*)(ws + OFF_WDN), DFF, DFF, DFF / 2);
            S.ks = 2;
            for (int u = blockIdx.x; u < 256; u += gridDim.x) {
                S.nM = 32; S.nN = 4; S.nwg = 128;
                int fpm, fpn; S.tile_of(u >> 1, fpm, fpn);
                conv_fixup(ws, pp->w_conv + (size_t)l * 3 * DFF2, pp->b_conv + (size_t)l * DFF2, fpm, (u & 1) * (DFF / 2));
            }
            EpiBf E{(bf16_t*)(ws + OFF_P), (bf16_t*)(ws + OFF_P1), 1024};
            RUN_GEMM(gemm_run(S, 32, 4, E, ldsh);)
        }
        xcd_barrier(xb);
    }
    RUN_NORM(phase_norm(kp, 2, 4, 1, 1 * 8 + 5, 0, 0);)
}

extern "C" void kernel_launch(void* const* d_in, const int* in_sizes, int n_in, void* d_out, int out_size, void* d_ws, size_t ws_size, hipStream_t stream) {
    static int grid_blocks = 0;
    if (!grid_blocks) {
        int dev = 0, cus = 0, per_cu = 0;
        hipGetDevice(&dev);
        hipDeviceGetAttribute(&cus, hipDeviceAttributeMultiprocessorCount, dev);
        if (hipFuncSetAttribute((const void*)fwd_megakernel, hipFuncAttributeMaxDynamicSharedMemorySize, LDS_BYTES) != hipSuccess) fprintf(stderr, "hipFuncSetAttribute failed\n");
        if (hipOccupancyMaxActiveBlocksPerMultiprocessor(&per_cu, (const void*)fwd_megakernel, NTHR, LDS_BYTES) != hipSuccess || per_cu < 1) fprintf(stderr, "occupancy query: %d per CU\n", per_cu);
        (void)hipGetLastError();
        grid_blocks = cus;
        if (ws_size < WS_END) fprintf(stderr, "workspace too small: %zu < %zu\n", ws_size, (size_t)WS_END);
    }
    Params p{};
    p.x_prompt = (const float*)d_in[0]; p.x_sample = (const float*)d_in[1]; p.state_hgrn = (const float*)d_in[2]; p.state_ret = (const float*)d_in[3];
    p.c = (const float*)d_in[4]; p.c_ctx = (const float*)d_in[5]; p.norm1 = (const float*)d_in[6]; p.norm2 = (const float*)d_in[7]; p.final_norm = (const float*)d_in[8];
    p.w_mod = (const float*)d_in[9]; p.b_mod = (const float*)d_in[10]; p.w_in = (const float*)d_in[11]; p.lb_raw = (const float*)d_in[12];
    p.p_a = (const float*)d_in[13]; p.p_b = (const float*)d_in[14]; p.w_out = (const float*)d_in[15]; p.w_up = (const float*)d_in[16];
    p.w_conv = (const float*)d_in[17]; p.b_conv = (const float*)d_in[18]; p.w_down = (const float*)d_in[19];
    p.out = (float*)d_out; p.ws = (unsigned char*)d_ws;
    (void)hipMemsetAsync((unsigned char*)d_ws + OFF_BAR, 0, 16384, stream);
    void* args[] = {&p};
    hipError_t e = hipLaunchCooperativeKernel((void*)fwd_megakernel, dim3(grid_blocks), dim3(NTHR), args, LDS_BYTES, stream);
    if (e != hipSuccess) fprintf(stderr, "cooperative launch failed: %s (grid %d)\n", hipGetErrorString(e), grid_blocks);
}
```

```cpp
#include <hip/hip_runtime.h>
#include <hip/hip_cooperative_groups.h>
#include <cstdio>
namespace cg = cooperative_groups;

typedef unsigned short bf16_t;
typedef short bf16x8 __attribute__((ext_vector_type(8)));
typedef float f32x4 __attribute__((ext_vector_type(4)));
typedef unsigned short u16x4 __attribute__((ext_vector_type(4)));
typedef unsigned short u16x8 __attribute__((ext_vector_type(8)));
typedef unsigned u32x4 __attribute__((ext_vector_type(4)));
typedef unsigned u32x2 __attribute__((ext_vector_type(2)));

#define DEV __device__ __forceinline__
#define LAS3 __attribute__((address_space(3)))

constexpr int D = 1024, NTOK = 8192, NCTX = 4096, INW = 13312, DFF = 2816, DFF2 = 5632;
constexpr int NTHR = 512;
constexpr int LDS_BYTES = 156 * 1024;
constexpr float EPS = 1e-6f;

constexpr size_t MB = 1024 * 1024;
constexpr size_t SZ_TOK_BF = (size_t)NTOK * 1024 * 2;
constexpr size_t OFF_WIN = 0;
constexpr size_t OFF_PA = OFF_WIN + (size_t)INW * 1024 * 2;
constexpr size_t OFF_PB = OFF_PA + (size_t)1024 * 1024 * 2;
constexpr size_t OFF_WOUT = OFF_PB + (size_t)1024 * 2048 * 2;
constexpr size_t OFF_WUP = OFF_WOUT + (size_t)1024 * 1024 * 2;
constexpr size_t OFF_WDN = OFF_WUP + (size_t)DFF2 * 1024 * 2;
constexpr size_t OFF_MODS = OFF_WDN + (size_t)1024 * DFF * 2;
constexpr size_t OFF_LB = OFF_MODS + 2 * 5 * 6144 * 4;
constexpr size_t OFF_ROPE = OFF_LB + 2 * 2 * 1024 * 4;
constexpr size_t OFF_H = ((OFF_ROPE + 64 * 64 * 2 * 4 + 4095) / 4096) * 4096;
constexpr size_t OFF_QA = OFF_H + SZ_TOK_BF;
constexpr size_t OFF_IA = OFF_QA + SZ_TOK_BF;
constexpr size_t OFF_GA = OFF_IA + SZ_TOK_BF;
constexpr size_t OFF_QB = OFF_GA + SZ_TOK_BF;
constexpr size_t OFF_KB = OFF_QB + SZ_TOK_BF;
constexpr size_t OFF_SGA = OFF_KB + SZ_TOK_BF;
constexpr size_t OFF_SGB = OFF_SGA + SZ_TOK_BF;
constexpr size_t OFF_VB = OFF_SGB + SZ_TOK_BF;
constexpr size_t OFF_GB = OFF_VB + 2 * SZ_TOK_BF;
constexpr size_t OFF_LFF = OFF_GB + 2 * SZ_TOK_BF;
constexpr size_t OFF_LFB = OFF_LFF + 2 * SZ_TOK_BF;
constexpr size_t OFF_OAF = OFF_LFB + 2 * SZ_TOK_BF;
constexpr size_t OFF_OAB = OFF_OAF + SZ_TOK_BF;
constexpr size_t OFF_OBF = OFF_OAB + SZ_TOK_BF;
constexpr size_t OFF_OBB = OFF_OBF + 2 * SZ_TOK_BF;
constexpr size_t OFF_BAR = OFF_OBB + 2 * SZ_TOK_BF;
constexpr size_t WS_END = OFF_BAR + 16384;
constexpr size_t OFF_OA = OFF_QA;
constexpr size_t OFF_OB = OFF_QB;
constexpr size_t OFF_MERGED = OFF_LFF;
constexpr size_t OFF_P = OFF_LFB;
constexpr size_t OFF_P1 = OFF_QA;
constexpr size_t OFF_UB = OFF_OAF;
constexpr size_t OFF_U = OFF_OAF;
constexpr size_t OFF_ACT = OFF_VB;

constexpr size_t OUT_Y = 0;
constexpr size_t OUT_SH = (size_t)NTOK * 1024;
constexpr size_t OUT_SR = OUT_SH + (size_t)16 * 2 * 2 * 8 * 128 * 128;

struct Params {
    const float *x_prompt, *x_sample, *state_hgrn, *state_ret, *c, *c_ctx, *norm1, *norm2, *final_norm, *w_mod, *b_mod, *w_in, *lb_raw, *p_a, *p_b, *w_out, *w_up,
        *w_conv, *b_conv, *w_down;
    float* out;
    unsigned char* ws;
};

typedef const __attribute__((address_space(4))) Params* KP;
DEV KP fresh(KP kp) { unsigned z; asm volatile("s_mov_b32 %0, 0" : "=s"(z)); return (KP)((const __attribute__((address_space(4))) char*)kp + z); }
DEV unsigned xb_add(unsigned* p, unsigned v) {
    unsigned old;
    asm volatile("global_atomic_add %0, %1, %2, off sc0\n\ts_waitcnt vmcnt(0)" : "=v"(old) : "v"(p), "v"(v) : "memory");
    return old;
}
DEV int otid() { int t = threadIdx.x; asm volatile("" : "+v"(t)); return t; }
typedef float f32x2n __attribute__((ext_vector_type(2)));
typedef __bf16 bf16x2n __attribute__((ext_vector_type(2)));
DEV unsigned pk2(float lo, float hi) { f32x2n v = {lo, hi}; return __builtin_bit_cast(unsigned, __builtin_convertvector(v, bf16x2n)); }
DEV bf16_t f2bf(float f) { return (bf16_t)(pk2(f, f) & 0xffffu); }
DEV void store_bf4(bf16_t* dst, f32x4 v) { u32x2 o; o[0] = pk2(v[0], v[1]); o[1] = pk2(v[2], v[3]); *(u32x2*)dst = o; }
DEV float bf2f(bf16_t b) { return __uint_as_float(((unsigned)b) << 16); }
DEV float sigmoidf_(float z) { return __builtin_amdgcn_rcpf(1.f + __expf(-z)); }
DEV float siluf_(float z) { return z * __builtin_amdgcn_rcpf(1.f + __expf(-z)); }
DEV float shfl_xor_l(float v, int o, int lane) { return __int_as_float(__builtin_amdgcn_ds_bpermute((lane ^ o) << 2, __float_as_int(v))); }
DEV float wave_sum(float v, int lane) {
#pragma unroll
    for (int o = 32; o > 0; o >>= 1) v += shfl_xor_l(v, o, lane);
    return v;
}
DEV int seq_row0(int s) { return s < 16 ? s * 256 : NCTX + (s - 16) * 1024; }
DEV int seq_len(int s) { return s < 16 ? 256 : 1024; }
DEV int row_modvec(int row) { return row < NCTX ? 0 : 1 + ((row - NCTX) >> 10); }

DEV void phase_mods(KP p, float* lds) {
    p = fresh(p);
    const int tid = otid();
    float* sv = lds;
    float* red = lds + 5 * 1024;
    for (int i = tid; i < 5 * 1024; i += NTHR) {
        int v = i >> 10, d = i & 1023;
        float cv = v == 0 ? p->c_ctx[d] : p->c[(v - 1) * 1024 + d];
        sv[i] = siluf_(cv);
    }
    __syncthreads();
    for (int it = blockIdx.x; it < 256; it += gridDim.x) {
        const int l = it >> 7, e0 = (it & 127) * 48;
        const int cq = tid % 12, r = tid / 12;
        f32x4 a0 = {0.f, 0.f, 0.f, 0.f}, a1 = a0, a2 = a0, a3 = a0, a4 = a0;
        if (r < 42) {
            const float* wp = p->w_mod + (size_t)l * 1024 * 6144 + e0 + 4 * cq;
#pragma unroll 4
            for (int d = r; d < 1024; d += 42) {
                const f32x4 w = __builtin_nontemporal_load((const f32x4*)(wp + (size_t)d * 6144));
                a0 += w * sv[d]; a1 += w * sv[1024 + d]; a2 += w * sv[2048 + d]; a3 += w * sv[3072 + d]; a4 += w * sv[4096 + d];
            }
            float* rp = red + (r * 12 + cq) * 20;
            *(f32x4*)(rp) = a0; *(f32x4*)(rp + 4) = a1; *(f32x4*)(rp + 8) = a2; *(f32x4*)(rp + 12) = a3; *(f32x4*)(rp + 16) = a4;
        }
        __syncthreads();
        if (tid < 240) {
            const int v = tid / 48, c = tid % 48;
            float sum = 0.f;
            for (int g = 0; g < 42; ++g) sum += red[(g * 12 + (c >> 2)) * 20 + v * 4 + (c & 3)];
            float* mods = (float*)(p->ws + OFF_MODS);
            mods[((size_t)l * 5 + v) * 6144 + e0 + c] = sum + p->b_mod[l * 6144 + e0 + c];
        }
        __syncthreads();
    }
    float* lb = (float*)(p->ws + OFF_LB);
    float* rope = (float*)(p->ws + OFF_ROPE);
    for (int i = blockIdx.x * NTHR + tid; i < 2048 + 4096; i += gridDim.x * NTHR) {
        if (i < 2048) {
            float r0 = p->lb_raw[i], r1 = p->lb_raw[2048 + i];
            lb[i] = 0.f;
            lb[2048 + i] = 1.f / (1.f + expf(r0 - r1));
        } else {
            int k = i - 2048, pos = k >> 6, j = k & 63;
            float inv = exp2f(-((float)j / 64.f) * 13.287712379549449f);
            float ang = (float)pos * inv;
            rope[2 * k] = __cosf(ang); rope[2 * k + 1] = __sinf(ang);
        }
    }
}

DEV int win_src_col(int n) {
    if (n < 5120 || n >= 7168) return n;
    const int e = n & 255, half = e >> 7, pp = e & 127, g = pp >> 3, r = pp & 7;
    const int orig = half * 128 + (r < 4 ? 4 * g + r : 64 + 4 * g + (r - 4));
    return (n - e) + orig;
}
DEV int wup_src_col(int n) {
    const int j = n >> 8, e = n & 255, q = e >> 3, r = e & 7;
    return r < 4 ? 128 * j + 4 * q + r : DFF + 128 * j + 4 * q + (r - 4);
}
DEV void convert_one(const float* W, int K, int N, bf16_t* Wt, int perm, int tile, float* lds) {
    const int nNt = N / 256;
    const int kt = tile / nNt, nt = tile % nNt;
    const int tid = otid();
    f32x4 v[8];
#pragma unroll
    for (int i = 0; i < 8; ++i) {
        const int idx = tid + NTHR * i, row = idx >> 6, c4 = idx & 63;
        const int srcc = perm == 2 ? (c4 < 32 ? 128 * nt + 4 * c4 : DFF + 128 * nt + 4 * (c4 - 32)) : nt * 256 + 4 * c4;
        v[i] = __builtin_nontemporal_load((const f32x4*)(W + (size_t)(kt * 64 + row) * N + srcc));
    }
#pragma unroll
    for (int i = 0; i < 8; ++i) {
        const int idx = tid + NTHR * i, row = idx >> 6, c4 = idx & 63;
        float* dp = lds + row * 257 + 4 * c4;
        dp[0] = v[i][0]; dp[1] = v[i][1]; dp[2] = v[i][2]; dp[3] = v[i][3];
    }
    __syncthreads();
    {
        const int k8 = tid & 7, nl = tid >> 3;
#pragma unroll
        for (int i = 0; i < 4; ++i) {
            const int n = nt * 256 + nl + 64 * i;
            const int sg = n & 255, pi = sg & 15;
            int np = (n & ~255) + 64 * ((sg >> 5) & 3) + 32 * (sg >> 7) + 8 * (pi >> 2) + 4 * ((sg >> 4) & 1) + (pi & 3);
            if (perm == 1 && n >= 1024 && n < 3072) np = (n & ~255) + 64 * ((sg >> 5) & 3) + 32 * (sg >> 7) + 16 * ((sg >> 4) & 1) + pi;
            int sc = (perm == 1 ? win_src_col(np) : np) - nt * 256;
            if (perm == 2) { const int e = np & 255, q = e >> 3, r = e & 7; sc = r < 4 ? 4 * q + r : 128 + 4 * q + (r - 4); }
            const float* sp = lds + (8 * k8) * 257 + sc;
            u32x4 o;
            o[0] = pk2(sp[0], sp[257]); o[1] = pk2(sp[2 * 257], sp[3 * 257]); o[2] = pk2(sp[4 * 257], sp[5 * 257]); o[3] = pk2(sp[6 * 257], sp[7 * 257]);
            *(u32x4*)(Wt + (size_t)n * K + kt * 64 + 8 * k8) = o;
        }
    }
    __syncthreads();
}
DEV void convert_tile(KP p, int l, int t, float* lds) {
    if (t < 832) convert_one(p->w_in + (size_t)l * 1024 * INW, 1024, INW, (bf16_t*)(p->ws + OFF_WIN), 1, t, lds);
    else if (t < 896) convert_one(p->p_a + (size_t)l * 1024 * 1024, 1024, 1024, (bf16_t*)(p->ws + OFF_PA), 0, t - 832, lds);
    else if (t < 1024) convert_one(p->p_b + (size_t)l * 2048 * 1024, 2048, 1024, (bf16_t*)(p->ws + OFF_PB), 0, t - 896, lds);
    else if (t < 1088) convert_one(p->w_out + (size_t)l * 1024 * 1024, 1024, 1024, (bf16_t*)(p->ws + OFF_WOUT), 0, t - 1024, lds);
    else if (t < 1440) convert_one(p->w_up + (size_t)l * 1024 * DFF2, 1024, DFF2, (bf16_t*)(p->ws + OFF_WUP), 2, t - 1088, lds);
    else convert_one(p->w_down + (size_t)l * DFF * 1024, DFF, 1024, (bf16_t*)(p->ws + OFF_WDN), 0, t - 1440, lds);
}
DEV void phase_convert(KP p, int l, float* lds) {
    p = fresh(p);
    for (int t = blockIdx.x; t < 1616; t += gridDim.x) convert_tile(p, l, t, lds);
}
DEV void convert_queue(KP p, float* lds, int cidx, int first, int last, int maxn) {
    p = fresh(p);
    unsigned* ctr = (unsigned*)(p->ws + OFF_BAR) + 3776 + 64 * cidx;
    volatile LAS3 unsigned* bc = (volatile LAS3 unsigned*)((LAS3 unsigned char*)lds + LDS_BYTES - 8);
    for (int k = 0; k < maxn; ++k) {
        __syncthreads();
        if (otid() == 0) *bc = xb_add(ctr, 1u);
        __syncthreads();
        const int t = first + (int)*bc;
        if (t >= last) break;
        convert_tile(p, 1, t, lds);
    }
    __syncthreads();
}

DEV void phase_norm(KP p, int mode, int nwsel, int lmod, int gate_idx, int sc_idx, int sh_idx) {
    p = fresh(p);
    const int tid = otid(), wid = tid >> 6, lane = tid & 63;
    const float* nw = nwsel < 2 ? p->norm1 + nwsel * 1024 : (nwsel < 4 ? p->norm2 + (nwsel - 2) * 1024 : p->final_norm);
    float* xbuf = p->out + OUT_Y;
    const bf16_t* P = (const bf16_t*)(p->ws + OFF_P);
    const bf16_t* P1 = (const bf16_t*)(p->ws + OFF_P1);
    const float* mods = (const float*)(p->ws + OFF_MODS);
    bf16_t* h = (bf16_t*)(p->ws + OFF_H);
    const float* xp = p->x_prompt; const float* xs = p->x_sample;
    const int stride = gridDim.x * 8;
    for (int row0 = blockIdx.x * 8 + wid; row0 < NTOK; row0 += 2 * stride) {
        f32x4 x[2][4], sc[2][4], sh[2][4], w[4];
        float ss[2] = {0.f, 0.f};
#pragma unroll
        for (int i = 0; i < 4; ++i) w[i] = *(const f32x4*)(nw + lane * 4 + 256 * i);
#pragma unroll
        for (int r = 0; r < 2; ++r) {
            const int row = row0 + r * stride;
            if (row < NTOK) {
                const int v = row_modvec(row);
#pragma unroll
                for (int i = 0; i < 4; ++i) {
                    const int c = lane * 4 + 256 * i;
                    if (mode == 0) {
                        const float* src = row < NCTX ? xp + (size_t)row * 1024 : xs + (size_t)(row - NCTX) * 1024;
                        x[r][i] = *(const f32x4*)(src + c);
                    } else {
                        x[r][i] = *(const f32x4*)(xbuf + (size_t)row * 1024 + c);
                        const u16x4 q0 = *(const u16x4*)(P + (size_t)row * 1024 + c), q1 = *(const u16x4*)(P1 + (size_t)row * 1024 + c);
                        const f32x4 g = *(const f32x4*)(mods + ((size_t)(gate_idx >> 3) * 5 + v) * 6144 + (gate_idx & 7) * 1024 + c);
                        f32x4 pv; pv[0] = bf2f(q0[0]) + bf2f(q1[0]); pv[1] = bf2f(q0[1]) + bf2f(q1[1]); pv[2] = bf2f(q0[2]) + bf2f(q1[2]); pv[3] = bf2f(q0[3]) + bf2f(q1[3]);
                        x[r][i] = x[r][i] + g * pv;
                    }
                    if (mode != 2) {
                        sc[r][i] = *(const f32x4*)(mods + ((size_t)lmod * 5 + v) * 6144 + sc_idx * 1024 + c);
                        sh[r][i] = *(const f32x4*)(mods + ((size_t)lmod * 5 + v) * 6144 + sh_idx * 1024 + c);
                    }
                    ss[r] += x[r][i][0] * x[r][i][0] + x[r][i][1] * x[r][i][1] + x[r][i][2] * x[r][i][2] + x[r][i][3] * x[r][i][3];
                }
            }
        }
        ss[0] = wave_sum(ss[0], lane); ss[1] = wave_sum(ss[1], lane);
#pragma unroll
        for (int r = 0; r < 2; ++r) {
            const int row = row0 + r * stride;
            if (row < NTOK) {
                const float rstd = rsqrtf(ss[r] * (1.f / 1024.f) + EPS);
#pragma unroll
                for (int i = 0; i < 4; ++i) {
                    const int c = lane * 4 + 256 * i;
                    if (mode == 2) {
                        *(f32x4*)(xbuf + (size_t)row * 1024 + c) = x[r][i] * rstd * w[i];
                    } else {
                        *(f32x4*)(xbuf + (size_t)row * 1024 + c) = x[r][i];
                        store_bf4(h + (size_t)row * 1024 + c, x[r][i] * rstd * w[i] * (sc[r][i] + 1.f) + sh[r][i]);
                    }
                }
            }
        }
    }
}

struct Seg { const bf16_t* A; const bf16_t* Bt; int lda, ldb, K; };

DEV void gemm_seg_simple(f32x4 (&acc)[2][2][4][2], const Seg& s, int pm, int pn, bf16_t* lds) {
    const int tid = otid(), wid = tid >> 6, lane = tid & 63, wr = wid >> 2, wc = wid & 3, fr = lane & 15, fq = lane >> 4;
    bf16_t* sA = lds;
    bf16_t* sB = lds + 256 * 40;
    const int lr = tid >> 2, lc = (tid & 3) * 8;
    for (int k0 = 0; k0 < s.K; k0 += 32) {
#pragma unroll
        for (int i = 0; i < 2; ++i) {
            const int r = lr + 128 * i;
            *(bf16x8*)(sA + r * 40 + lc) = *(const bf16x8*)(s.A + (size_t)(pm * 256 + r) * s.lda + k0 + lc);
            *(bf16x8*)(sB + r * 40 + lc) = *(const bf16x8*)(s.Bt + (size_t)(pn * 256 + r) * s.ldb + k0 + lc);
        }
        __syncthreads();
        bf16x8 bfr[2][2];
#pragma unroll
        for (int bj = 0; bj < 2; ++bj)
#pragma unroll
            for (int n = 0; n < 2; ++n) bfr[bj][n] = *(const bf16x8*)(sB + (128 * bj + 32 * wc + 16 * n + fr) * 40 + fq * 8);
#pragma unroll
        for (int ai = 0; ai < 2; ++ai)
#pragma unroll
            for (int m = 0; m < 4; ++m) {
                const bf16x8 af = *(const bf16x8*)(sA + (128 * ai + 64 * wr + 16 * m + fr) * 40 + fq * 8);
#pragma unroll
                for (int bj = 0; bj < 2; ++bj)
#pragma unroll
                    for (int n = 0; n < 2; ++n) acc[ai][bj][m][n] = __builtin_amdgcn_mfma_f32_16x16x32_bf16(bfr[bj][n], af, acc[ai][bj][m][n], 0, 0, 0);
            }
        __syncthreads();
    }
}

template <class F>
DEV void for_acc(f32x4 (&acc)[2][2][4][2], int pm, int pn, F f) {
    const int tid = otid(), wid = tid >> 6, lane = tid & 63, wr = wid >> 2, wc = wid & 3, fr = lane & 15, fq = lane >> 4;
#pragma unroll
    for (int a = 0; a < 2; ++a)
#pragma unroll
        for (int b = 0; b < 2; ++b)
#pragma unroll
            for (int m = 0; m < 4; ++m)
#pragma unroll
                for (int n = 0; n < 2; ++n) f(pm * 256 + 128 * a + 64 * wr + 16 * m + fr, pn * 256 + 64 * wc + 32 * b + 8 * fq + 4 * n, acc[a][b][m][n]);
}
template <class F>
DEV void for_acc2(f32x4 (&acc)[2][2][4][2], int pm, int pn, F f) {
    const int tid = otid(), wid = tid >> 6, lane = tid & 63, wr = wid >> 2, wc = wid & 3, fr = lane & 15, fq = lane >> 4;
#pragma unroll
    for (int a = 0; a < 2; ++a)
#pragma unroll
        for (int b = 0; b < 2; ++b)
#pragma unroll
            for (int m = 0; m < 4; ++m) f(pm * 256 + 128 * a + 64 * wr + 16 * m + fr, pn * 256 + 64 * wc + 32 * b + 8 * fq, acc[a][b][m][0], acc[a][b][m][1]);
}
DEV void zero_acc(f32x4 (&acc)[2][2][4][2]) {
#pragma unroll
    for (int a = 0; a < 2; ++a)
#pragma unroll
        for (int b = 0; b < 2; ++b)
#pragma unroll
            for (int m = 0; m < 4; ++m)
#pragma unroll
                for (int n = 0; n < 2; ++n) acc[a][b][m][n] = (f32x4){0.f, 0.f, 0.f, 0.f};
}

template <class Epi>
DEV void gemm_phase_simple(int nM, int nN, const Seg s0, const Seg s1, bool two, const Epi& E, bf16_t* lds) {
    for (int u = blockIdx.x; u < nM * nN; u += gridDim.x) {
        const int pm = u % nM, pn = u / nM;
        f32x4 acc[2][2][4][2];
        zero_acc(acc);
        gemm_seg_simple(acc, s0, pm, pn, lds);
        if (two) {
            E.mid(acc, pm, pn);
            gemm_seg_simple(acc, s1, pm, pn, lds);
        }
        E.fin(acc, pm, pn);
    }
}

#define LAS __attribute__((address_space(3)))
constexpr int HTB = 128 * 64 * 2;
DEV int lds_byte(int r, int c) { const int st = (r >> 4) * 2 + (c >> 5), rr = r & 15, cc = c & 31, ob = rr * 64 + cc * 2; return st * 1024 + (ob ^ (((ob >> 9) & 1) << 5)); }
DEV void stage_rc(int b, int& R, int& C) { const int st = b / 1024, sb = b % 1024, swz = sb ^ (((sb >> 9) & 1) << 5); R = (st >> 1) * 16 + swz / 64; C = (st & 1) * 32 + (swz % 64) / 2; }
struct Step { const char* A; const char* B; unsigned lda, ldb; int nt, pm, pn, kind, half; };
struct Prog {
    const bf16_t *A0, *B0, *A1, *B1; int lda0, ldb0, K0, lda1, ldb1, K1a, K1b, mode, ks, bsame, pnmap;
    int nM, nN, nwg, G, c;
    int j, stp;
    DEV void tile_of(int t, int& pm, int& pn) const {
        int wgid = t; { const int q = nwg / 8, r = nwg % 8, xcd = wgid % 8, off = wgid / 8; wgid = (xcd < r ? xcd * (q + 1) : r * (q + 1) + (xcd - r) * q) + off; }
        const int nig = 8 * nN, gid = wgid / nig, fm = gid * 8, gsz = (nM - fm) < 8 ? (nM - fm) : 8;
        pm = fm + ((wgid % nig) % gsz); pn = (wgid % nig) / gsz;
        if (pnmap == 1) pn = pn < 16 ? pn : pn + 4;
        else if (pnmap == 2) pn = pn < 4 ? 16 + pn : 32 + pn;
    }
    DEV bool next(Step& st) {
        const long L = (long)j * G + c;
        if (L >= (long)nwg * ks) return false;
        const int u = (int)L, tile = u / ks, half = u % ks;
        tile_of(tile, st.pm, st.pn); st.half = half;
        if (mode == 0) {
            st.lda = lda0 * 2; st.ldb = ldb0 * 2; st.nt = K0 / 64; st.kind = 0;
            const bf16_t* a = (half && A1) ? A1 : A0 + (size_t)half * K0 * (A1 ? 0 : 1);
            const bf16_t* bq = B0 + (size_t)half * K0 * (bsame ? 0 : 1);
            st.A = (const char*)a + (size_t)st.pm * 256 * st.lda; st.B = (const char*)bq + (size_t)st.pn * 256 * st.ldb;
            ++j;
        } else {
            if (half == 0 && stp == 0) {
                st.lda = lda0 * 2; st.ldb = ldb0 * 2; st.nt = K0 / 64; st.kind = 1;
                st.A = (const char*)A0 + (size_t)st.pm * 256 * st.lda; st.B = (const char*)B0 + (size_t)st.pn * 256 * st.ldb;
                stp = 1;
            } else {
                st.lda = lda1 * 2; st.ldb = ldb1 * 2; st.kind = 0;
                const int koff = half ? K1a : 0; st.nt = (half ? K1b : K1a) / 64;
                st.A = (const char*)(A1 + koff) + (size_t)st.pm * 256 * st.lda; st.B = (const char*)(B1 + koff) + (size_t)st.pn * 256 * st.ldb;
                stp = 0; ++j;
            }
        }
        return true;
    }
};
template <class Epi>
DEV void gemm_phase8(LAS unsigned char* lds, Prog& S, const Epi& E) {
    const int tid = otid(), wid = __builtin_amdgcn_readfirstlane(tid >> 6), lane = tid & 63, wr = wid >> 2, wc = wid & 3, fr = lane & 15, fq = lane >> 4;
    unsigned sR[2], sC2[2];
#pragma unroll
    for (int i = 0; i < 2; ++i) { int R, C; stage_rc(tid * 16 + i * 8192, R, C); sR[i] = (unsigned)R; sC2[i] = (unsigned)C * 2u; }
    const size_t kstep = 128;
    const unsigned ldsw = (unsigned)wid * 1024u;
    const int aoff = lds_byte(wr * 64 + fr, fq * 8), boff = lds_byte(wc * 32 + fr, fq * 8);
#define G8_SA(b, h) (((b) * 2 + (h)) * HTB)
#define G8_SB(b, h) ((4 + (b) * 2 + (h)) * HTB)
#define G8_STAGE(bufoff, gbase, ld) do { _Pragma("unroll") for (int _i = 0; _i < 2; ++_i) \
        __builtin_amdgcn_global_load_lds((const unsigned*)((const char*)(gbase) + (size_t)(sR[_i] * (ld) + sC2[_i])), (LAS unsigned*)(lds + (bufoff) + ldsw + _i * 8192), 16, 0, 0); } while (0)
#define G8_LDA(dst, b, h) do { _Pragma("unroll") for (int m = 0; m < 4; ++m) _Pragma("unroll") for (int k = 0; k < 2; ++k) dst[m][k] = *(const LAS bf16x8*)(lds + G8_SA(b, h) + aoff + m * 2048 + k * 1024); } while (0)
#define G8_LDB(dst, b, h) do { _Pragma("unroll") for (int n = 0; n < 2; ++n) _Pragma("unroll") for (int k = 0; k < 2; ++k) dst[n][k] = *(const LAS bf16x8*)(lds + G8_SB(b, h) + boff + n * 2048 + k * 1024); } while (0)
#define G8_MMA(ai, bj, At, Bt) do { __builtin_amdgcn_s_setprio(1); _Pragma("unroll") for (int m = 0; m < 4; ++m) _Pragma("unroll") for (int n = 0; n < 2; ++n) _Pragma("unroll") for (int k = 0; k < 2; ++k) \
        acc[ai][bj][m][n] = __builtin_amdgcn_mfma_f32_16x16x32_bf16(Bt[n][k], At[m][k], acc[ai][bj][m][n], 0, 0, 0); __builtin_amdgcn_s_setprio(0); } while (0)
#define G8_WAIT_V(n) asm volatile("s_waitcnt vmcnt(" #n ")" ::: "memory")
#define G8_WAIT_L(n) asm volatile("s_waitcnt lgkmcnt(" #n ")" ::: "memory")
#define G8_BAR __builtin_amdgcn_s_barrier()
#define G8_SCHED __builtin_amdgcn_sched_barrier(0)
    Step cur, nxt;
    if (!S.next(cur)) return;
    f32x4 acc[2][2][4][2];
    zero_acc(acc);
    bf16x8 At[4][2], B0[2][2], B1[2][2];
    {
        const char* cA = cur.A; const char* cB = cur.B; const unsigned la = cur.lda, lb = cur.ldb; const size_t hA = (size_t)128 * la, hB = (size_t)128 * lb;
        G8_STAGE(G8_SB(0, 0), cB, lb); G8_STAGE(G8_SA(0, 0), cA, la); G8_STAGE(G8_SB(0, 1), cB + hB, lb); G8_STAGE(G8_SA(0, 1), cA + hA, la);
        if (wr == 1) G8_BAR;
        G8_WAIT_V(4); G8_BAR;
        G8_STAGE(G8_SB(1, 0), cB + kstep, lb); G8_STAGE(G8_SA(1, 0), cA + kstep, la); G8_STAGE(G8_SB(1, 1), cB + hB + kstep, lb);
        G8_WAIT_V(6); G8_BAR;
    }
    for (;;) {
        const bool has_next = S.next(nxt);
        if (!has_next) nxt = cur;
        const char* cA = cur.A; const char* cB = cur.B; const unsigned la = cur.lda, lb = cur.ldb; const size_t hA = (size_t)128 * la, hB = (size_t)128 * lb;
        const int nt = cur.nt;
        for (int t = 0; t < nt; t += 2) {
            const bool last = (t == nt - 2);
            const char* a1 = cA + (size_t)(t + 1) * kstep;
            const char* a2 = last ? nxt.A : cA + (size_t)(t + 2) * kstep; const char* b2 = last ? nxt.B : cB + (size_t)(t + 2) * kstep;
            const unsigned la2 = last ? nxt.lda : la, lb2 = last ? nxt.ldb : lb; const size_t hA2 = (size_t)128 * la2, hB2 = (size_t)128 * lb2;
            const char* a3 = a2 + kstep; const char* b3 = b2 + kstep;
            G8_LDB(B0, 0, 0); G8_SCHED; G8_LDA(At, 0, 0); G8_STAGE(G8_SA(1, 1), a1 + hA, la);
            G8_WAIT_L(8); G8_BAR; G8_WAIT_L(0); G8_MMA(0, 0, At, B0); G8_BAR; G8_SCHED;
            G8_LDB(B1, 0, 1); G8_STAGE(G8_SB(0, 0), b2, lb2);
            G8_BAR; G8_WAIT_L(0); G8_MMA(0, 1, At, B1); G8_BAR;
            G8_LDA(At, 0, 1); G8_STAGE(G8_SA(0, 0), a2, la2);
            G8_BAR; G8_WAIT_L(0); G8_MMA(1, 0, At, B0); G8_BAR; G8_SCHED;
            G8_STAGE(G8_SB(0, 1), b2 + hB2, lb2);
            G8_WAIT_V(6); G8_BAR; G8_MMA(1, 1, At, B1); G8_BAR;
            G8_LDB(B0, 1, 0); G8_SCHED; G8_LDA(At, 1, 0); G8_STAGE(G8_SA(0, 1), a2 + hA2, la2);
            G8_WAIT_L(8); G8_BAR; G8_WAIT_L(0); G8_MMA(0, 0, At, B0); G8_BAR; G8_SCHED;
            G8_LDB(B1, 1, 1); G8_STAGE(G8_SB(1, 0), b3, lb2);
            G8_BAR; G8_WAIT_L(0); G8_MMA(0, 1, At, B1); G8_BAR;
            G8_LDA(At, 1, 1); G8_STAGE(G8_SA(1, 0), a3, la2);
            G8_BAR; G8_WAIT_L(0); G8_MMA(1, 0, At, B0); G8_BAR; G8_SCHED;
            G8_STAGE(G8_SB(1, 1), b3 + hB2, lb2);
            G8_WAIT_V(6); G8_BAR; G8_MMA(1, 1, At, B1); G8_BAR;
        }
        if (cur.kind == 1) E.mid(acc, cur.pm, cur.pn);
        else { E.fin(acc, cur.pm, cur.pn, cur.half); }
        if (!has_next) break;
        if (cur.kind == 0) zero_acc(acc);
        cur = nxt;
    }
    G8_WAIT_V(0);
    if (wr == 0) G8_BAR;
    G8_BAR;
#undef G8_SA
#undef G8_SB
#undef G8_STAGE
#undef G8_LDA
#undef G8_LDB
#undef G8_MMA
#undef G8_WAIT_V
#undef G8_WAIT_L
#undef G8_BAR
#undef G8_SCHED
}
template <class Epi>
DEV void gemm_run(Prog S, int nM, int nN, const Epi& E, bf16_t* ldsg) {
    S.nM = nM; S.nN = nN; S.nwg = nM * nN; S.G = gridDim.x; S.c = blockIdx.x; S.j = 0; S.stp = 0;
    gemm_phase8((LAS unsigned char*)ldsg, S, E);
}
template <class Epi>
DEV void gemm_one(Prog S, int nM, int nN, int unit, const Epi& E, bf16_t* ldsg) {
    S.nM = nM; S.nN = nN; S.nwg = nM * nN; S.G = 1 << 24; S.c = unit; S.j = 0; S.stp = 0;
    gemm_phase8((LAS unsigned char*)ldsg, S, E);
}
DEV Prog prog_plain(const bf16_t* A, const bf16_t* Bt, int lda, int ldb, int K) {
    Prog S; S.A0 = A; S.B0 = Bt; S.A1 = nullptr; S.B1 = nullptr; S.lda0 = lda; S.ldb0 = ldb; S.K0 = K; S.lda1 = 0; S.ldb1 = 0; S.K1a = 0; S.K1b = 0; S.mode = 0; S.ks = 1; S.bsame = 0; S.pnmap = 0; return S;
}


DEV u32x4 pack8(f32x4 v0, f32x4 v1) { u32x4 o; o[0] = pk2(v0[0], v0[1]); o[1] = pk2(v0[2], v0[3]); o[2] = pk2(v1[0], v1[1]); o[3] = pk2(v1[2], v1[3]); return o; }
DEV void stage_rows(bf16_t* dst, int ld, int rowbase, int colbase, u32x4 v0, u32x4 v1, int w, int fr, int fq, int lane) {
    extern __shared__ __attribute__((aligned(16))) unsigned char smem_x[];
    unsigned char* st = smem_x + 131072 + w * 2304;
    *(u32x4*)(st + fr * 144 + 16 * fq) = v0;
    *(u32x4*)(st + fr * 144 + 64 + 16 * fq) = v1;
    __builtin_amdgcn_wave_barrier();
    const int r = lane >> 3, pc = lane & 7;
    const u32x4 o0 = *(const u32x4*)(st + r * 144 + 16 * pc), o1 = *(const u32x4*)(st + (8 + r) * 144 + 16 * pc);
    *(u32x4*)(dst + (size_t)(rowbase + r) * ld + colbase + 8 * pc) = o0;
    *(u32x4*)(dst + (size_t)(rowbase + 8 + r) * ld + colbase + 8 * pc) = o1;
    __builtin_amdgcn_wave_barrier();
}
template <class G>
DEV void store_tile_rows(f32x4 (&acc)[2][2][4][2], int pm, bf16_t* dst, int ld, int coloff, G g) {
    const int tid = otid(), wid = tid >> 6, lane = tid & 63, wr = wid >> 2, wc = wid & 3, fr = lane & 15, fq = lane >> 4;
#pragma unroll
    for (int a = 0; a < 2; ++a)
#pragma unroll
        for (int m = 0; m < 4; ++m)
            stage_rows(dst, ld, pm * 256 + 128 * a + 64 * wr + 16 * m, coloff + 64 * wc, pack8(g(acc[a][0][m][0]), g(acc[a][0][m][1])), pack8(g(acc[a][1][m][0]), g(acc[a][1][m][1])), wid, fr, fq, lane);
}
DEV float logf_gate(float z, float lb) {
    const float e = __expf(-fabsf(z));
    const float r = __builtin_amdgcn_rcpf(1.f + e);
    const float sig = z >= 0.f ? r : e * r;
    return __builtin_amdgcn_logf(lb + (1.f - lb) * sig) * 0.6931471805599453f;
}

struct EpiInProj {
    unsigned char* ws; int l;
    DEV void mid(f32x4 (&)[2][2][4][2], int, int) const {}
    DEV void fin(f32x4 (&acc)[2][2][4][2], int pm, int pn, int half) const {
        const int col0 = pn * 256;
        unsigned char* w = ws; const int ll = l;
        if (col0 < 1024) { store_tile_rows(acc, pm, (bf16_t*)(w + OFF_QA), 1024, pn * 256 - 0, [](f32x4 v) { return v; }); }
        else if (col0 < 3072) {
            const int dir = col0 >= 2048;
            const float* lbp = (const float*)(w + OFF_LB) + (ll * 2 + dir) * 1024;
            float* dst = (float*)(w + (dir ? OFF_LFB : OFF_LFF));
            {
                const int tid = otid(), wid = tid >> 6, lane = tid & 63, wr = wid >> 2, wc = wid & 3, fr = lane & 15, fq = lane >> 4;
                const int cb = pn * 256 - 1024 - dir * 1024 + 64 * wc + 4 * fq;
                f32x4 lb4[2][2];
#pragma unroll
                for (int b = 0; b < 2; ++b)
#pragma unroll
                    for (int n = 0; n < 2; ++n) lb4[b][n] = *(const f32x4*)(lbp + cb + 32 * b + 16 * n);
#pragma unroll
                for (int a = 0; a < 2; ++a)
#pragma unroll
                    for (int m = 0; m < 4; ++m)
#pragma unroll
                        for (int b = 0; b < 2; ++b)
#pragma unroll
                            for (int n = 0; n < 2; ++n) {
                                const int row = pm * 256 + 128 * a + 64 * wr + 16 * m + fr;
                                f32x4 o;
#pragma unroll
                                for (int j = 0; j < 4; ++j) o[j] = logf_gate(acc[a][b][m][n][j], lb4[b][n][j]);
                                *(f32x4*)(dst + (size_t)row * 1024 + cb + 32 * b + 16 * n) = o;
                            }
            }
        }
        else if (col0 < 4096) { store_tile_rows(acc, pm, (bf16_t*)(w + OFF_IA), 1024, pn * 256 - 3072, [](f32x4 v) { return v; }); }
        else if (col0 < 5120) { store_tile_rows(acc, pm, (bf16_t*)(w + OFF_GA), 1024, pn * 256 - 4096, [](f32x4 v) { return v; }); }
        else if (col0 < 7168) {
            const int isk = col0 >= 6144;
            const float scale = isk ? 0.0625f : 1.f;
            bf16_t* dbase = (bf16_t*)(w + (isk ? OFF_KB : OFF_QB));
            const float* rope = (const float*)(w + OFF_ROPE);
            {
                const int tid = otid(), wid = tid >> 6, lane = tid & 63, wr = wid >> 2, wc = wid & 3, fr = lane & 15, fq = lane >> 4;
#pragma unroll
                for (int a = 0; a < 2; ++a) {
                    f32x4 cs0[2][4], cs1[2][4];
#pragma unroll
                    for (int b = 0; b < 2; ++b)
#pragma unroll
                        for (int m = 0; m < 4; ++m) {
                            const int row = pm * 256 + 128 * a + 64 * wr + 16 * m + fr;
                            const int g = 8 * (wc & 1) + 4 * b + fq;
                            const int t = (row - NCTX) & 1023, pos = (wc >> 1) ? (t & 63) : (t >> 6);
                            cs0[b][m] = *(const f32x4*)(rope + (pos * 64 + 4 * g) * 2); cs1[b][m] = *(const f32x4*)(rope + (pos * 64 + 4 * g) * 2 + 4);
                        }
#pragma unroll
                    for (int b = 0; b < 2; ++b)
#pragma unroll
                        for (int m = 0; m < 4; ++m) {
                            const int row = pm * 256 + 128 * a + 64 * wr + 16 * m + fr;
                            const int g = 8 * (wc & 1) + 4 * b + fq, hh = pn & 3;
                            const f32x4 x1 = acc[a][b][m][0] * scale, x2 = acc[a][b][m][1] * scale;
                            f32x4 o1 = x1, o2 = x2;
                            if (row >= NCTX) {
                                const f32x4 c0 = cs0[b][m], c1 = cs1[b][m];
                                o1[0] = x1[0] * c0[0] - x2[0] * c0[1]; o2[0] = x1[0] * c0[1] + x2[0] * c0[0];
                                o1[1] = x1[1] * c0[2] - x2[1] * c0[3]; o2[1] = x1[1] * c0[3] + x2[1] * c0[2];
                                o1[2] = x1[2] * c1[0] - x2[2] * c1[1]; o2[2] = x1[2] * c1[1] + x2[2] * c1[0];
                                o1[3] = x1[3] * c1[2] - x2[3] * c1[3]; o2[3] = x1[3] * c1[3] + x2[3] * c1[2];
                            }
                            bf16_t* dstp = dbase + (size_t)row * 1024 + hh * 256 + (wc >> 1) * 128 + 4 * g;
                            store_bf4(dstp, o1);
                            store_bf4(dstp + 64, o2);
                        }
                }
            }
        }
        else if (col0 < 9216) { store_tile_rows(acc, pm, (bf16_t*)(w + OFF_VB), 2048, pn * 256 - 7168, [](f32x4 v) { return v; }); }
        else if (col0 < 11264) { store_tile_rows(acc, pm, (bf16_t*)(w + OFF_GB), 2048, pn * 256 - 9216, [](f32x4 v) { return v; }); }
        else {
            const int isb = col0 >= 12288;
            bf16_t* dbase = (bf16_t*)(w + (isb ? OFF_SGB : OFF_SGA));
            store_tile_rows(acc, pm, dbase, 1024, pn * 256 - 11264 - isb * 1024, [](f32x4 v) { f32x4 o; o[0] = sigmoidf_(v[0]); o[1] = sigmoidf_(v[1]); o[2] = sigmoidf_(v[2]); o[3] = sigmoidf_(v[3]); return o; });
        }
    }
};
struct EpiMerged {
    unsigned char* ws;
    DEV void mid(f32x4 (&acc)[2][2][4][2], int pm, int pn) const {
        const bf16_t* sga = (const bf16_t*)(ws + OFF_SGA); const bf16_t* sgb = (const bf16_t*)(ws + OFF_SGB);
        for_acc(acc, pm, pn, [&](int row, int col, f32x4& v) {
            const u16x4 a = *(const u16x4*)(sga + (size_t)row * 1024 + col);
            const u16x4 b = *(const u16x4*)(sgb + (size_t)row * 1024 + col);
#pragma unroll
            for (int j = 0; j < 4; ++j) v[j] *= bf2f(a[j]) * __builtin_amdgcn_rcpf(fmaxf(bf2f(b[j]), 1e-30f));
        });
    }
    DEV void fin(f32x4 (&acc)[2][2][4][2], int pm, int pn, int half) const {
        const bf16_t* sgb = (const bf16_t*)(ws + OFF_SGB); bf16_t* mg = (bf16_t*)(ws + OFF_MERGED) + (size_t)half * NTOK * 1024;
        const int tid = otid(), wid = tid >> 6, lane = tid & 63, wr = wid >> 2, wc = wid & 3, fr = lane & 15, fq = lane >> 4;
        const int cb = pn * 256 + 64 * wc + 8 * fq;
#pragma unroll
        for (int a = 0; a < 2; ++a) {
            u16x8 gb[2][4];
#pragma unroll
            for (int b = 0; b < 2; ++b)
#pragma unroll
                for (int m = 0; m < 4; ++m) gb[b][m] = *(const u16x8*)(sgb + (size_t)(pm * 256 + 128 * a + 64 * wr + 16 * m + fr) * 1024 + cb + 32 * b);
#pragma unroll
            for (int b = 0; b < 2; ++b)
#pragma unroll
                for (int m = 0; m < 4; ++m) {
                    const size_t off = (size_t)(pm * 256 + 128 * a + 64 * wr + 16 * m + fr) * 1024 + cb + 32 * b;
                    u32x4 o;
#pragma unroll
                    for (int n = 0; n < 2; ++n) {
                        const f32x4 v = acc[a][b][m][n];
                        o[2 * n] = pk2(v[0] * fmaxf(bf2f(gb[b][m][4 * n]), 1e-30f), v[1] * fmaxf(bf2f(gb[b][m][4 * n + 1]), 1e-30f));
                        o[2 * n + 1] = pk2(v[2] * fmaxf(bf2f(gb[b][m][4 * n + 2]), 1e-30f), v[3] * fmaxf(bf2f(gb[b][m][4 * n + 3]), 1e-30f));
                    }
                    *(u32x4*)(mg + off) = o;
                }
        }
    }
};
struct EpiF32 {
    float* C; float* C1; int ldc;
    DEV void mid(f32x4 (&)[2][2][4][2], int, int) const {}
    DEV void fin(f32x4 (&acc)[2][2][4][2], int pm, int pn, int half) const {
        float* c = half ? C1 : C; const int ld = ldc;
        for_acc(acc, pm, pn, [&](int row, int col, f32x4& v) { *(f32x4*)(c + (size_t)row * ld + col) = v; });
    }
};
struct EpiBf {
    bf16_t* C; bf16_t* C1; int ldc;
    DEV void mid(f32x4 (&)[2][2][4][2], int, int) const {}
    DEV void fin(f32x4 (&acc)[2][2][4][2], int pm, int pn, int half) const {
        bf16_t* c = half ? C1 : C; const int ld = ldc;
        store_tile_rows(acc, pm, c, ld, pn * 256, [](f32x4 v) { return v; });
    }
};

#define ROR1(x)  __int_as_float(__builtin_amdgcn_update_dpp(0, __float_as_int(x), 0x121, 0xf, 0xf, false))
#define ROR15(x) __int_as_float(__builtin_amdgcn_update_dpp(0, __float_as_int(x), 0x12F, 0xf, 0xf, false))
struct EpiUpConv {
    unsigned char* ws; const float* wc_; const float* bc_;
    DEV void mid(f32x4 (&)[2][2][4][2], int, int) const {}
    DEV void fin(f32x4 (&acc)[2][2][4][2], int pm, int pn, int) const {
        const int tid = otid(), wid = tid >> 6, lane = tid & 63, wr = wid >> 2, wc = wid & 3, fr = lane & 15, fq = lane >> 4;
        bf16_t* act = (bf16_t*)(ws + OFF_ACT); bf16_t* ub = (bf16_t*)(ws + OFF_UB);
        const int ip = ((lane & 48) | ((fr + 15) & 15)) << 2, in = ((lane & 48) | ((fr + 1) & 15)) << 2;
#pragma unroll
        for (int b = 0; b < 2; ++b) {
            const int ch = pn * 128 + 4 * (8 * wc + 4 * b + fq);
            const f32x4 wa0 = *(const f32x4*)(wc_ + ch), wa1 = *(const f32x4*)(wc_ + DFF2 + ch), wa2 = *(const f32x4*)(wc_ + 2 * DFF2 + ch), ba = *(const f32x4*)(bc_ + ch);
            const f32x4 wg0 = *(const f32x4*)(wc_ + DFF + ch), wg1 = *(const f32x4*)(wc_ + DFF2 + DFF + ch), wg2 = *(const f32x4*)(wc_ + 2 * DFF2 + DFF + ch), bg = *(const f32x4*)(bc_ + DFF + ch);
#pragma unroll
            for (int a = 0; a < 2; ++a)
#pragma unroll
                for (int m = 0; m < 4; ++m) {
                    const int row = pm * 256 + 128 * a + 64 * wr + 16 * m + fr;
                    f32x4 pa, na, pg, ng;
#pragma unroll
                    for (int j = 0; j < 4; ++j) {
                        const float ca = acc[a][b][m][0][j], cg = acc[a][b][m][1][j];
                        const float sa_p = (m > 0 && fr == 15) ? acc[a][b][m > 0 ? m - 1 : 0][0][j] : ((m == 0 && fr == 15) ? 0.f : ca);
                        const float sg_p = (m > 0 && fr == 15) ? acc[a][b][m > 0 ? m - 1 : 0][1][j] : ((m == 0 && fr == 15) ? 0.f : cg);
                        const float sa_n = (m < 3 && fr == 0) ? acc[a][b][m < 3 ? m + 1 : 3][0][j] : ((m == 3 && fr == 0) ? 0.f : ca);
                        const float sg_n = (m < 3 && fr == 0) ? acc[a][b][m < 3 ? m + 1 : 3][1][j] : ((m == 3 && fr == 0) ? 0.f : cg);
                        pa[j] = ROR1(sa_p); pg[j] = ROR1(sg_p);
                        na[j] = ROR15(sa_n); ng[j] = ROR15(sg_n);
                    }
                    const f32x4 va = ba + wa0 * pa + wa1 * acc[a][b][m][0] + wa2 * na;
                    const f32x4 vg = bg + wg0 * pg + wg1 * acc[a][b][m][1] + wg2 * ng;
                    f32x4 o;
#pragma unroll
                    for (int j = 0; j < 4; ++j) o[j] = siluf_(vg[j]) * va[j];
                    store_bf4(act + (size_t)row * DFF + ch, o);
                    const int pos = row & 63;
                    if (pos < 2 || pos >= 62) {
                        bf16_t* up = ub + (size_t)((row >> 6) * 4 + (pos < 2 ? pos : pos - 60)) * DFF2;
                        store_bf4(up + ch, acc[a][b][m][0]);
                        store_bf4(up + DFF + ch, acc[a][b][m][1]);
                    }
                }
        }
    }
};
DEV void conv_fixup(unsigned char* ws, const float* wc_, const float* bc_, int pm, int c0) {
    const int tid = otid();
    bf16_t* act = (bf16_t*)(ws + OFF_ACT); const bf16_t* ub = (const bf16_t*)(ws + OFF_UB);
    for (int idx = tid; idx < 8 * 352; idx += NTHR) {
        const int ri = idx / 352, cq = idx % 352, ch = c0 + 4 * cq;
        const int R = pm * 256 + (ri >> 1) * 64 + ((ri & 1) ? 63 : 0);
        const int t = R < NCTX ? (R & 255) : ((R - NCTX) & 1023), T = R < NCTX ? 256 : 1024;
        const int blk = R >> 6;
        const bf16_t *rp, *rc, *rn;
        if (ri & 1) { rp = ub + (size_t)(blk * 4 + 2) * DFF2; rc = ub + (size_t)(blk * 4 + 3) * DFF2; rn = ub + (size_t)((blk + 1) * 4 + 0) * DFF2; }
        else { rp = ub + (size_t)((blk - 1) * 4 + 3) * DFF2; rc = ub + (size_t)(blk * 4 + 0) * DFF2; rn = ub + (size_t)(blk * 4 + 1) * DFF2; }
        const bool hp = t > 0, hn = t < T - 1;
        f32x4 va = *(const f32x4*)(bc_ + ch), vg = *(const f32x4*)(bc_ + DFF + ch);
        {
            const u16x4 xa = *(const u16x4*)(rc + ch), xg = *(const u16x4*)(rc + DFF + ch);
            const f32x4 wa = *(const f32x4*)(wc_ + DFF2 + ch), wg = *(const f32x4*)(wc_ + DFF2 + DFF + ch);
#pragma unroll
            for (int j = 0; j < 4; ++j) { va[j] += wa[j] * bf2f(xa[j]); vg[j] += wg[j] * bf2f(xg[j]); }
        }
        if (hp) {
            const u16x4 xa = *(const u16x4*)(rp + ch), xg = *(const u16x4*)(rp + DFF + ch);
            const f32x4 wa = *(const f32x4*)(wc_ + ch), wg = *(const f32x4*)(wc_ + DFF + ch);
#pragma unroll
            for (int j = 0; j < 4; ++j) { va[j] += wa[j] * bf2f(xa[j]); vg[j] += wg[j] * bf2f(xg[j]); }
        }
        if (hn) {
            const u16x4 xa = *(const u16x4*)(rn + ch), xg = *(const u16x4*)(rn + DFF + ch);
            const f32x4 wa = *(const f32x4*)(wc_ + 2 * DFF2 + ch), wg = *(const f32x4*)(wc_ + 2 * DFF2 + DFF + ch);
#pragma unroll
            for (int j = 0; j < 4; ++j) { va[j] += wa[j] * bf2f(xa[j]); vg[j] += wg[j] * bf2f(xg[j]); }
        }
        f32x4 o;
#pragma unroll
        for (int j = 0; j < 4; ++j) o[j] = siluf_(vg[j]) * va[j];
        store_bf4(act + (size_t)R * DFF + ch, o);
    }
    asm volatile("s_waitcnt vmcnt(0)" ::: "memory");
    __syncthreads();
}

DEV bf16x8 frag4(unsigned a, unsigned b, unsigned c, unsigned d) { u32x4 v; v[0] = a; v[1] = b; v[2] = c; v[3] = d; return __builtin_bit_cast(bf16x8, v); }
DEV bf16x8 ld16(const bf16_t* p) { return *(const bf16x8*)p; }
DEV u32x2 ld8(const bf16_t* p) { return *(const u32x2*)p; }
#define MFMA16(a, b, c) __builtin_amdgcn_mfma_f32_16x16x32_bf16(a, b, c, 0, 0, 0)

DEV void scan_ret_mfma(KP p, int l, int it, unsigned char* lds) {
    const int tid0 = otid();
    int s, head, dir, sl;
    if (it < 64) { s = 16 + (it >> 4); head = (it >> 2) & 3; dir = (it >> 1) & 1; sl = it & 1; }
    else { const int k = it - 64; s = k >> 4; head = (k >> 2) & 3; dir = (k >> 1) & 1; sl = k & 1; }
    const int row0 = seq_row0(s), T = seq_len(s);
    bf16_t* Qs = (bf16_t*)lds;
    bf16_t* Ks = Qs + 64 * 264;
    bf16_t* Kt = Ks + 64 * 264;
    bf16_t* Vt = Kt + 256 * 72;
    bf16_t* Ps = Vt + 256 * 72;
    float* gp = (float*)(Ps + 64 * 72);
    const bf16_t* qb = (const bf16_t*)(p->ws + OFF_QB);
    const bf16_t* kb = (const bf16_t*)(p->ws + OFF_KB);
    const bf16_t* vb = (const bf16_t*)(p->ws + OFF_VB);
    bf16_t* oo = (bf16_t*)(p->ws + (dir ? OFF_OBB : OFF_OBF));
    const float gamma = 1.f - exp2f(-(5.f + (dir ? 0.5f : 0.f)) - (float)head);
    const float lg2 = log2f(gamma);
    bf16x8 pq[4], pk[4], pv[4];
#define RET_ISSUE_QK(cc) do { const int tq_ = tid >> 5, c8_ = tid & 31; _Pragma("unroll") for (int i = 0; i < 4; ++i) { const int j = 4 * tq_ + i, tok = dir ? (T - 1 - ((cc) + j)) : ((cc) + j); \
        const size_t g = (size_t)(row0 + tok) * 1024 + head * 256 + c8_ * 8; pq[i] = *(const bf16x8*)(qb + g); pk[i] = *(const bf16x8*)(kb + g); } } while (0)
#define RET_ISSUE_V(cc) do { const int tq_ = tid >> 5, c8_ = tid & 31; _Pragma("unroll") for (int i = 0; i < 4; ++i) { const int j = 4 * tq_ + i, tok = dir ? (T - 1 - ((cc) + j)) : ((cc) + j); \
        pv[i] = *(const bf16x8*)(vb + (size_t)(row0 + tok) * 2048 + head * 512 + sl * 256 + 8 * c8_); } } while (0)
    { const int tid = tid0; RET_ISSUE_QK(0); RET_ISSUE_V(0); }
    __syncthreads();
    if (tid0 < 65) gp[tid0] = exp2f((float)tid0 * lg2);
    f32x4 S[16][2];
    {
        const int w = tid0 >> 6, fr = tid0 & 15, fq = (tid0 >> 4) & 3;
        if (s >= 16) {
            const float* st = p->state_ret + ((((size_t)(s - 16) * 2 + l) * 2 + dir) * 4 + head) * 256 * 512 + sl * 256 + 32 * w + 8 * (fr >> 2) + (fr & 3);
#pragma unroll
            for (int dt = 0; dt < 16; ++dt)
#pragma unroll
                for (int dvt = 0; dvt < 2; ++dvt)
#pragma unroll
                    for (int jj = 0; jj < 4; ++jj) S[dt][dvt][jj] = st[(size_t)(16 * dt + 4 * fq + jj) * 512 + 4 * dvt];
        } else {
#pragma unroll
            for (int dt = 0; dt < 16; ++dt) { S[dt][0] = (f32x4){0.f, 0.f, 0.f, 0.f}; S[dt][1] = (f32x4){0.f, 0.f, 0.f, 0.f}; }
        }
    }
    for (int c0 = 0; c0 < T; c0 += 64) {
        int tid = tid0; asm volatile("" : "+v"(tid));
        const int w = tid >> 6, lane = tid & 63, fr = lane & 15, fq = lane >> 4, tq = tid >> 5, c8 = tid & 31;
        __syncthreads();
        {
            const float g0 = gp[63 - 4 * tq], g1 = gp[62 - 4 * tq], g2 = gp[61 - 4 * tq], g3 = gp[60 - 4 * tq];
#pragma unroll
            for (int i = 0; i < 4; ++i) { *(bf16x8*)(Qs + (4 * tq + i) * 264 + c8 * 8) = pq[i]; *(bf16x8*)(Ks + (4 * tq + i) * 264 + c8 * 8) = pk[i]; }
            const int kpos = 8 * ((tq >> 1) ^ (c8 & 7)) + 4 * (tq & 1);
#pragma unroll
            for (int c = 0; c < 8; ++c) {
                u32x2 o;
                o[0] = pk2(bf2f((bf16_t)pk[0][c]) * g0, bf2f((bf16_t)pk[1][c]) * g1);
                o[1] = pk2(bf2f((bf16_t)pk[2][c]) * g2, bf2f((bf16_t)pk[3][c]) * g3);
                *(u32x2*)(Kt + (c8 * 8 + c) * 72 + kpos) = o;
                if (c & 1) __builtin_amdgcn_sched_barrier(0);
            }
#pragma unroll
            for (int c = 0; c < 8; ++c) {
                u32x2 o;
                o[0] = (unsigned)(bf16_t)pv[0][c] | ((unsigned)(bf16_t)pv[1][c] << 16);
                o[1] = (unsigned)(bf16_t)pv[2][c] | ((unsigned)(bf16_t)pv[3][c] << 16);
                *(u32x2*)(Vt + (c8 * 8 + c) * 72 + kpos) = o;
                if (c & 1) __builtin_amdgcn_sched_barrier(0);
            }
        }
        __syncthreads();
#pragma unroll
        for (int h = 0; h < 2; ++h) {
            const int idx = w + 8 * h, ti = idx >> 2, tj = idx & 3;
            f32x4 acc = (f32x4){0.f, 0.f, 0.f, 0.f};
            if (tj <= ti) {
#pragma unroll
                for (int ks = 0; ks < 8; ++ks)
                    acc = MFMA16(ld16(Ks + (16 * tj + fr) * 264 + 32 * ks + 8 * fq), ld16(Qs + (16 * ti + fr) * 264 + 32 * ks + 8 * fq), acc);
                const int i = 16 * ti + fr, j0 = 16 * tj + 4 * fq;
#pragma unroll
                for (int jj = 0; jj < 4; ++jj) { const int d = i - (j0 + jj); acc[jj] = d >= 0 ? acc[jj] * gp[d >= 0 ? d : 0] : 0.f; }
            }
            u32x2 o; o[0] = pk2(acc[0], acc[1]); o[1] = pk2(acc[2], acc[3]);
            *(u32x2*)(Ps + (16 * ti + fr) * 72 + 16 * tj + 4 * fq) = o;
        }
        __syncthreads();
        const int dv0 = 32 * w + 8 * (fr >> 2) + (fr & 3), dv1 = dv0 + 4;
        const int vsw0 = (dv0 >> 3) & 7, vsw1 = (dv1 >> 3) & 7;
        const bf16_t* vrow0 = Vt + dv0 * 72; const bf16_t* vrow1 = Vt + dv1 * 72;
        const bf16x8 vf00 = ld16(vrow0 + 8 * (fq ^ vsw0)), vf01 = ld16(vrow0 + 8 * ((4 + fq) ^ vsw0));
        const bf16x8 vf10 = ld16(vrow1 + 8 * (fq ^ vsw1)), vf11 = ld16(vrow1 + 8 * ((4 + fq) ^ vsw1));
        {
            f32x4 o[4][2];
#pragma unroll
            for (int tt = 0; tt < 4; ++tt) { o[tt][0] = (f32x4){0.f, 0.f, 0.f, 0.f}; o[tt][1] = (f32x4){0.f, 0.f, 0.f, 0.f}; }
            const bf16_t* qbase = Qs + fr * 264 + 4 * fq;
#pragma unroll
            for (int q = 0; q < 8; ++q) {
                const bf16x8 sf0 = frag4(pk2(S[2 * q][0][0], S[2 * q][0][1]), pk2(S[2 * q][0][2], S[2 * q][0][3]), pk2(S[2 * q + 1][0][0], S[2 * q + 1][0][1]), pk2(S[2 * q + 1][0][2], S[2 * q + 1][0][3]));
                const bf16x8 sf1 = frag4(pk2(S[2 * q][1][0], S[2 * q][1][1]), pk2(S[2 * q][1][2], S[2 * q][1][3]), pk2(S[2 * q + 1][1][0], S[2 * q + 1][1][1]), pk2(S[2 * q + 1][1][2], S[2 * q + 1][1][3]));
#pragma unroll
                for (int tt = 0; tt < 4; ++tt) {
                    const u32x2 b0 = ld8(qbase + 16 * tt * 264 + 32 * q), b1 = ld8(qbase + 16 * tt * 264 + 32 * q + 16);
                    const bf16x8 bq = frag4(b0[0], b0[1], b1[0], b1[1]);
                    o[tt][0] = MFMA16(sf0, bq, o[tt][0]);
                    o[tt][1] = MFMA16(sf1, bq, o[tt][1]);
                }
                __builtin_amdgcn_sched_barrier(0);
            }
            const bf16_t* pbase = Ps + fr * 72 + 8 * fq;
            const float* gbase = gp + fr + 1;
            const int i0 = c0 + fr;
#pragma unroll
            for (int tt = 0; tt < 4; ++tt) {
                const float sc = gbase[16 * tt];
                o[tt][0] = o[tt][0] * sc; o[tt][1] = o[tt][1] * sc;
                const bf16x8 p0 = ld16(pbase + 16 * tt * 72), p1 = ld16(pbase + 16 * tt * 72 + 32);
                o[tt][0] = MFMA16(vf00, p0, o[tt][0]); o[tt][0] = MFMA16(vf01, p1, o[tt][0]);
                o[tt][1] = MFMA16(vf10, p0, o[tt][1]); o[tt][1] = MFMA16(vf11, p1, o[tt][1]);
                const int pos = i0 + 16 * tt, tok = dir ? (T - 1 - pos) : pos;
                bf16_t* op = oo + (size_t)(row0 + tok) * 2048 + head * 512 + sl * 256 + 32 * w + 8 * fq;
                u32x4 ov; ov[0] = pk2(o[tt][0][0], o[tt][0][1]); ov[1] = pk2(o[tt][0][2], o[tt][0][3]); ov[2] = pk2(o[tt][1][0], o[tt][1][1]); ov[3] = pk2(o[tt][1][2], o[tt][1][3]);
                *(u32x4*)op = ov;
                __builtin_amdgcn_sched_barrier(0);
            }
        }
        __builtin_amdgcn_sched_barrier(0);
        if (c0 + 64 < T) RET_ISSUE_QK(c0 + 64);
        __builtin_amdgcn_sched_barrier(0);
        {
            const float g64 = gp[64];
            const bf16_t* kbase = Kt + fr * 72;
            const int kswb = (fr >> 3) & 1;
#pragma unroll
            for (int dt = 0; dt < 16; ++dt) {
                const int ksw = (2 * dt + kswb) & 7;
                const bf16x8 k0 = ld16(kbase + 16 * dt * 72 + 8 * (fq ^ ksw)), k1 = ld16(kbase + 16 * dt * 72 + 8 * ((4 + fq) ^ ksw));
                S[dt][0] = S[dt][0] * g64; S[dt][1] = S[dt][1] * g64;
                S[dt][0] = MFMA16(k0, vf00, S[dt][0]); S[dt][0] = MFMA16(k1, vf01, S[dt][0]);
                S[dt][1] = MFMA16(k0, vf10, S[dt][1]); S[dt][1] = MFMA16(k1, vf11, S[dt][1]);
                if (dt & 1) __builtin_amdgcn_sched_barrier(0);
            }
        }
        if (c0 + 64 < T) RET_ISSUE_V(c0 + 64);
    }
#undef RET_ISSUE_QK
#undef RET_ISSUE_V
    if (s < 16) {
        const int w = tid0 >> 6, fr = tid0 & 15, fq = (tid0 >> 4) & 3;
        float* st = p->out + OUT_SR + ((((size_t)s * 2 + l) * 2 + dir) * 4 + head) * 256 * 512 + sl * 256 + 32 * w + 8 * (fr >> 2) + (fr & 3);
#pragma unroll
        for (int dt = 0; dt < 16; ++dt)
#pragma unroll
            for (int dvt = 0; dvt < 2; ++dvt)
#pragma unroll
                for (int jj = 0; jj < 4; ++jj) st[(size_t)(16 * dt + 4 * fq + jj) * 512 + 4 * dvt] = S[dt][dvt][jj];
    }
}

DEV void scan_hgrn_mfma(KP p, int l, int it, unsigned char* lds) {
    const int tid = otid(), w = tid >> 6, lane = tid & 63, fr = lane & 15, fq = lane >> 4;
    int s, head, dir;
    if (it < 64) { s = 16 + (it >> 4); head = (it >> 1) & 7; dir = it & 1; }
    else { const int k = it - 64; s = k >> 4; head = (k >> 1) & 7; dir = k & 1; }
    const int row0 = seq_row0(s), T = seq_len(s);
    bf16_t* Qd = (bf16_t*)lds;
    bf16_t* Kn = Qd + 4 * 16 * 136;
    bf16_t* Kdt = Kn + 4 * 16 * 136;
    bf16_t* Vt = Kdt + 4 * 128 * 24;
    float* ae = (float*)(Vt + 4 * 128 * 24);
    const float* lfp = (const float*)(p->ws + (dir ? OFF_LFB : OFF_LFF));
    const bf16_t* qa = (const bf16_t*)(p->ws + OFF_QA);
    const bf16_t* ia = (const bf16_t*)(p->ws + OFF_IA);
    bf16_t* oo = (bf16_t*)(p->ws + (dir ? OFF_OAB : OFF_OAF));
    const int d = tid & 127, sub = tid >> 7;
    float plf[16]; bf16_t pqv[16], pvv[16];
#define HG_ISSUE(cc) do { _Pragma("unroll") for (int i = 0; i < 16; ++i) { const int pos = (cc) + 16 * sub + i, tok = dir ? (T - 1 - pos) : pos; \
        const size_t g = (size_t)(row0 + tok) * 1024 + head * 128 + d; plf[i] = lfp[g]; pqv[i] = qa[g]; pvv[i] = ia[g]; } } while (0)
    HG_ISSUE(0);
    f32x4 S[8];
    if (s >= 16) {
        const float* st = p->state_hgrn + ((((size_t)(s - 16) * 2 + l) * 2 + dir) * 8 + head) * 128 * 128 + 16 * w + fr;
#pragma unroll
        for (int dt = 0; dt < 8; ++dt)
#pragma unroll
            for (int jj = 0; jj < 4; ++jj) S[dt][jj] = st[(size_t)(16 * dt + 4 * fq + jj) * 128];
    } else {
#pragma unroll
        for (int dt = 0; dt < 8; ++dt) S[dt] = (f32x4){0.f, 0.f, 0.f, 0.f};
    }
    for (int c0 = 0; c0 < T; c0 += 64) {
        __syncthreads();
        {
            float cum = 0.f;
            float kn[16];
            unsigned vpk[8], kpk[8];
#pragma unroll
            for (int i = 0; i < 16; ++i) {
                const float lf = plf[i] * 1.4426950408889634f;
                cum += lf;
                const float k = 1.f - __builtin_amdgcn_exp2f(lf), q = bf2f(pqv[i]);
                const unsigned v = pvv[i];
                const float ec = __builtin_amdgcn_exp2f(fmaxf(cum, -100.f)), en = __builtin_amdgcn_rcpf(ec);
                Qd[(sub * 16 + i) * 136 + d] = f2bf(q * ec);
                kn[i] = k * en;
                Kn[(sub * 16 + i) * 136 + d] = f2bf(kn[i]);
                if (i & 1) vpk[i >> 1] |= v << 16; else vpk[i >> 1] = v;
            }
            const float aend = __builtin_amdgcn_exp2f(fmaxf(cum, -100.f));
            ae[sub * 128 + d] = aend;
#pragma unroll
            for (int i = 0; i < 8; ++i) kpk[i] = pk2(kn[2 * i] * aend, kn[2 * i + 1] * aend);
            u32x4 t0, t1;
            t0[0] = kpk[0]; t0[1] = kpk[1]; t0[2] = kpk[2]; t0[3] = kpk[3]; t1[0] = kpk[4]; t1[1] = kpk[5]; t1[2] = kpk[6]; t1[3] = kpk[7];
            *(u32x4*)(Kdt + (sub * 128 + d) * 24) = t0; *(u32x4*)(Kdt + (sub * 128 + d) * 24 + 8) = t1;
            t0[0] = vpk[0]; t0[1] = vpk[1]; t0[2] = vpk[2]; t0[3] = vpk[3]; t1[0] = vpk[4]; t1[1] = vpk[5]; t1[2] = vpk[6]; t1[3] = vpk[7];
            *(u32x4*)(Vt + (sub * 128 + d) * 24) = t0; *(u32x4*)(Vt + (sub * 128 + d) * 24 + 8) = t1;
        }
        if (c0 + 64 < T) HG_ISSUE(c0 + 64);
        __syncthreads();
#pragma unroll
        for (int sc = 0; sc < 4; ++sc) {
            const bf16_t* qd = Qd + sc * 16 * 136; const bf16_t* knp = Kn + sc * 16 * 136;
            const bf16_t* kdt = Kdt + sc * 128 * 24; const bf16_t* vt = Vt + sc * 128 * 24;
            f32x4 pa = (f32x4){0.f, 0.f, 0.f, 0.f};
#pragma unroll
            for (int ks = 0; ks < 4; ++ks) pa = MFMA16(ld16(knp + fr * 136 + 32 * ks + 8 * fq), ld16(qd + fr * 136 + 32 * ks + 8 * fq), pa);
#pragma unroll
            for (int jj = 0; jj < 4; ++jj) pa[jj] = (4 * fq + jj <= fr) ? pa[jj] : 0.f;
            const bf16x8 pb = frag4(pk2(pa[0], pa[1]), pk2(pa[2], pa[3]), 0u, 0u);
            f32x4 o = (f32x4){0.f, 0.f, 0.f, 0.f};
#pragma unroll
            for (int q = 0; q < 4; ++q) {
                const bf16x8 sf = frag4(pk2(S[2 * q][0], S[2 * q][1]), pk2(S[2 * q][2], S[2 * q][3]), pk2(S[2 * q + 1][0], S[2 * q + 1][1]), pk2(S[2 * q + 1][2], S[2 * q + 1][3]));
                const u32x2 b0 = ld8(qd + fr * 136 + 32 * q + 4 * fq), b1 = ld8(qd + fr * 136 + 32 * q + 16 + 4 * fq);
                o = MFMA16(sf, frag4(b0[0], b0[1], b1[0], b1[1]), o);
            }
            {
                const u32x2 va = ld8(vt + (16 * w + fr) * 24 + 4 * fq);
                o = MFMA16(frag4(va[0], va[1], 0u, 0u), pb, o);
            }
            {
                const int pos = c0 + 16 * sc + fr, tok = dir ? (T - 1 - pos) : pos;
                u32x2 ov; ov[0] = pk2(o[0], o[1]); ov[1] = pk2(o[2], o[3]);
                *(u32x2*)(oo + (size_t)(row0 + tok) * 1024 + head * 128 + 16 * w + 4 * fq) = ov;
            }
            bf16x8 vf = frag4(0u, 0u, 0u, 0u);
            if (fq < 2) vf = ld16(vt + (16 * w + fr) * 24 + 8 * fq);
#pragma unroll
            for (int dt = 0; dt < 8; ++dt) {
                const f32x4 a4 = *(const f32x4*)(ae + sc * 128 + 16 * dt + 4 * fq);
                S[dt] = S[dt] * a4;
                bf16x8 kf = frag4(0u, 0u, 0u, 0u);
                if (fq < 2) kf = ld16(kdt + (16 * dt + fr) * 24 + 8 * fq);
                S[dt] = MFMA16(kf, vf, S[dt]);
            }
        }
    }
#undef HG_ISSUE
    if (s < 16) {
        float* st = p->out + OUT_SH + ((((size_t)s * 2 + l) * 2 + dir) * 8 + head) * 128 * 128 + 16 * w + fr;
#pragma unroll
        for (int dt = 0; dt < 8; ++dt)
#pragma unroll
            for (int jj = 0; jj < 4; ++jj) st[(size_t)(16 * dt + 4 * fq + jj) * 128] = S[dt][jj];
    }
}

DEV void phase_scan(KP p, int l, float* lds, int qi) {
    p = fresh(p);
    unsigned* qctr = (unsigned*)(p->ws + OFF_BAR) + 3520 + 64 * qi;
    volatile LAS3 unsigned* bc = (volatile LAS3 unsigned*)((LAS3 unsigned char*)lds + LDS_BYTES - 8);
    for (;;) {
        __syncthreads();
        if (otid() == 0) *bc = xb_add(qctr, 1u);
        __syncthreads();
        const int it = (int)*bc;
        if (it >= 1280) break;
        if (it < 64) scan_ret_mfma(p, l, it, (unsigned char*)lds);
        else if (it < 128) scan_hgrn_mfma(p, l, it - 64, (unsigned char*)lds);
        else if (it < 768) {
            unsigned char* ws = p->ws;
            EpiInProj E{ws, l};
            Prog S = prog_plain((const bf16_t*)(ws + OFF_H), (const bf16_t*)(ws + OFF_WIN), 1024, 1024, 1024);
            S.pnmap = 2;
            gemm_one(S, 32, 20, it - 128, E, (bf16_t*)lds);
        }
        else if (it < 1024) scan_ret_mfma(p, l, it - 768 + 64, (unsigned char*)lds);
        else scan_hgrn_mfma(p, l, it - 1024 + 64, (unsigned char*)lds);
    }
    __syncthreads();
}

DEV void phase_combine(KP p) {
    p = fresh(p);
    const int tid = otid(), wid = tid >> 6, lane = tid & 63;
    const bf16_t* oaf = (const bf16_t*)(p->ws + OFF_OAF); const bf16_t* oab = (const bf16_t*)(p->ws + OFF_OAB);
    const bf16_t* obf = (const bf16_t*)(p->ws + OFF_OBF); const bf16_t* obb = (const bf16_t*)(p->ws + OFF_OBB);
    const bf16_t* ga = (const bf16_t*)(p->ws + OFF_GA); const bf16_t* gb = (const bf16_t*)(p->ws + OFF_GB);
    bf16_t* oa = (bf16_t*)(p->ws + OFF_OA); bf16_t* ob = (bf16_t*)(p->ws + OFF_OB);
    const int stride = gridDim.x * 8;
    for (int row0 = blockIdx.x * 8 + wid; row0 < NTOK; row0 += 2 * stride) {
        u16x8 af[2][2], ab[2][2], ag[2][2], bf[2][4], bb[2][4], bg[2][4];
#pragma unroll
        for (int r = 0; r < 2; ++r) {
            const int row = row0 + r * stride;
            if (row < NTOK) {
                const size_t ba = (size_t)row * 1024 + lane * 16, bbs = (size_t)row * 2048 + lane * 32;
#pragma unroll
                for (int h8 = 0; h8 < 2; ++h8) { af[r][h8] = *(const u16x8*)(oaf + ba + h8 * 8); ab[r][h8] = *(const u16x8*)(oab + ba + h8 * 8); ag[r][h8] = *(const u16x8*)(ga + ba + h8 * 8); }
#pragma unroll
                for (int h8 = 0; h8 < 4; ++h8) { bf[r][h8] = *(const u16x8*)(obf + bbs + h8 * 8); bb[r][h8] = *(const u16x8*)(obb + bbs + h8 * 8); bg[r][h8] = *(const u16x8*)(gb + bbs + h8 * 8); }
            }
        }
#pragma unroll
        for (int r = 0; r < 2; ++r) {
            const int row = row0 + r * stride;
            if (row < NTOK) {
                {
                    const size_t base = (size_t)row * 1024 + lane * 16;
                    float o[16]; float ss = 0.f;
#pragma unroll
                    for (int h8 = 0; h8 < 2; ++h8)
#pragma unroll
                        for (int i = 0; i < 8; ++i) { o[h8 * 8 + i] = bf2f(af[r][h8][i]) + bf2f(ab[r][h8][i]); ss += o[h8 * 8 + i] * o[h8 * 8 + i]; }
                    ss += shfl_xor_l(ss, 1, lane); ss += shfl_xor_l(ss, 2, lane); ss += shfl_xor_l(ss, 4, lane);
                    const float rstd = rsqrtf(ss * (1.f / 128.f) + EPS);
#pragma unroll
                    for (int h8 = 0; h8 < 2; ++h8) {
                        u32x4 rr;
#pragma unroll
                        for (int i = 0; i < 4; ++i) rr[i] = pk2(o[h8 * 8 + 2 * i] * rstd * siluf_(bf2f(ag[r][h8][2 * i])), o[h8 * 8 + 2 * i + 1] * rstd * siluf_(bf2f(ag[r][h8][2 * i + 1])));
                        *(u32x4*)(oa + base + h8 * 8) = rr;
                    }
                }
                {
                    const size_t base = (size_t)row * 2048 + lane * 32;
                    float o[32]; float ss = 0.f;
#pragma unroll
                    for (int h8 = 0; h8 < 4; ++h8)
#pragma unroll
                        for (int i = 0; i < 8; ++i) { o[h8 * 8 + i] = bf2f(bf[r][h8][i]) + bf2f(bb[r][h8][i]); ss += o[h8 * 8 + i] * o[h8 * 8 + i]; }
                    ss += shfl_xor_l(ss, 1, lane); ss += shfl_xor_l(ss, 2, lane); ss += shfl_xor_l(ss, 4, lane); ss += shfl_xor_l(ss, 8, lane);
                    const float rstd = rsqrtf(ss * (1.f / 512.f) + EPS);
#pragma unroll
                    for (int h8 = 0; h8 < 4; ++h8) {
                        u32x4 rr;
#pragma unroll
                        for (int i = 0; i < 4; ++i) rr[i] = pk2(o[h8 * 8 + 2 * i] * rstd * siluf_(bf2f(bg[r][h8][2 * i])), o[h8 * 8 + 2 * i + 1] * rstd * siluf_(bf2f(bg[r][h8][2 * i + 1])));
                        *(u32x4*)(ob + base + h8 * 8) = rr;
                    }
                }
            }
        }
    }
}

DEV void phase_convact(KP p, int l) {
    p = fresh(p);
    const bf16_t* u = (const bf16_t*)(p->ws + OFF_U);
    bf16_t* act = (bf16_t*)(p->ws + OFF_ACT);
    const float* wc = p->w_conv + (size_t)l * 3 * DFF2;
    const float* bc = p->b_conv + (size_t)l * DFF2;
    const int total = NTOK * (DFF / 8);
    for (int i = blockIdx.x * NTHR + otid(); i < total; i += gridDim.x * NTHR) {
        const int row = i / (DFF / 8), f = (i % (DFF / 8)) * 8;
        int t, T;
        if (row < NCTX) { t = row & 255; T = 256; } else { t = (row - NCTX) & 1023; T = 1024; }
        float ca[8], cgv[8];
#pragma unroll
        for (int k = 0; k < 8; ++k) { ca[k] = bc[f + k]; cgv[k] = bc[DFF + f + k]; }
#pragma unroll
        for (int dt = -1; dt <= 1; ++dt) {
            if (t + dt < 0 || t + dt >= T) continue;
            const bf16_t* ur = u + (size_t)(row + dt) * DFF2;
            const u16x8 ua = *(const u16x8*)(ur + f), ug = *(const u16x8*)(ur + DFF + f);
            const float* w = wc + (dt + 1) * DFF2;
#pragma unroll
            for (int k = 0; k < 8; ++k) { ca[k] += bf2f(ua[k]) * w[f + k]; cgv[k] += bf2f(ug[k]) * w[DFF + f + k]; }
        }
        u16x8 r;
#pragma unroll
        for (int k = 0; k < 8; ++k) r[k] = f2bf(siluf_(cgv[k]) * ca[k]);
        *(u16x8*)(act + (size_t)row * DFF + f) = r;
    }
}

#define XB_TMO      128
#define XB_XCNT(j)  (256  + 64 * (j))
#define XB_XSUB(j)  (1280 + 64 * (j))
#define XB_XGEN(j)  (2304 + 64 * (j))
#define XB_TOP      3328
#define XB_TOPGEN   3392
#define XCD_BAR_WORDS 3456
#define XB_SPIN_CAP (1u << 18)
DEV unsigned xb_ld(unsigned* p) { return __hip_atomic_load(p, __ATOMIC_RELAXED, __HIP_MEMORY_SCOPE_AGENT); }
DEV unsigned xb_xcc_id() { return (unsigned)__builtin_amdgcn_s_getreg((3 << 11) | 20) & 0xFu; }
#define XB_SPIN(cond, bar) do { unsigned _sp = 0; while (cond) { __builtin_amdgcn_s_sleep(1); \
    if ((++_sp & 255u) == 0u) { if (xb_ld(&(bar)[XB_TMO])) break; if (_sp > XB_SPIN_CAP) { (void)xb_add(&(bar)[XB_TMO], 1u); break; } } } } while (0)
struct XcdBarrier { KP kp; volatile LAS3 unsigned* st; };
DEV XcdBarrier xcd_barrier_post(KP kp, volatile LAS3 unsigned* st) {
    XcdBarrier b; b.kp = kp; b.st = st;
    unsigned* bar = (unsigned*)(kp->ws + OFF_BAR);
    if (threadIdx.x == 0) (void)xb_add(&bar[XB_XCNT(xb_xcc_id())], 1u);
    return b;
}
DEV void xcd_barrier_complete(unsigned* bar, unsigned x, unsigned& nloc, unsigned& nx) {
    const unsigned G = gridDim.x * gridDim.y * gridDim.z;
    unsigned sum, cnt, mine, sp = 0u;
    for (;;) {
        sum = 0u; cnt = 0u; mine = 0u;
#pragma unroll
        for (unsigned j = 0; j < 16; ++j) { const unsigned c = xb_ld(&bar[XB_XCNT(j)]); sum += c; cnt += (c > 0u) ? 1u : 0u; mine = (j == x) ? c : mine; }
        if (sum == G) break;
        __builtin_amdgcn_s_sleep(1);
        if ((++sp & 255u) == 0u) { if (xb_ld(&bar[XB_TMO])) break; if (sp > XB_SPIN_CAP) { (void)xb_add(&bar[XB_TMO], 1u); break; } }
    }
    nloc = mine > 0u ? mine : 1u; nx = cnt > 0u ? cnt : 1u;
}
DEV void xcd_barrier(const XcdBarrier& b) {
    asm volatile("s_waitcnt vmcnt(0)" ::: "memory");
    __syncthreads();
    if (threadIdx.x == 0) {
        unsigned* bar = (unsigned*)(fresh(b.kp)->ws + OFF_BAR);
        const unsigned bx = xb_xcc_id();
        __builtin_amdgcn_s_waitcnt(0);
        unsigned nloc = b.st[0], nx = b.st[1];
        if (nloc == 0u) { xcd_barrier_complete(bar, bx, nloc, nx); b.st[0] = nloc; b.st[1] = nx; }
        const unsigned old = xb_add(&bar[XB_XSUB(bx)], 1u);
        const unsigned gen = old / nloc;
        if (old + 1u == (gen + 1u) * nloc) {
            __builtin_amdgcn_fence(__ATOMIC_RELEASE, "agent");
            asm volatile("s_waitcnt vmcnt(0)" ::: "memory");
            const unsigned og = xb_add(&bar[XB_TOP], 1u);
            const unsigned tg = og / nx;
            if (og + 1u == (tg + 1u) * nx) xb_add(&bar[XB_TOPGEN], 1u);
            else XB_SPIN(xb_ld(&bar[XB_TOPGEN]) == tg, bar);
            __builtin_amdgcn_fence(__ATOMIC_ACQUIRE, "agent");
            xb_add(&bar[XB_XGEN(bx)], 1u);
            asm volatile("s_waitcnt vmcnt(0)" ::: "memory");
        } else {
            XB_SPIN(xb_ld(&bar[XB_XGEN(bx)]) == gen, bar);
            __builtin_amdgcn_fence(__ATOMIC_ACQUIRE, "agent");
            asm volatile("s_waitcnt vmcnt(0)" ::: "memory");
        }
    }
    __syncthreads();
}

#ifndef SKIP_MODS
#define RUN_MODS(x) x
#else
#define RUN_MODS(x)
#endif
#ifndef SKIP_CONV
#define RUN_CONV(x) x
#else
#define RUN_CONV(x)
#endif
#ifndef SKIP_NORM
#define RUN_NORM(x) x
#else
#define RUN_NORM(x)
#endif
#if defined(DUP_GEMM)
#define RUN_GEMM(x) x x
#elif !defined(SKIP_GEMM)
#define RUN_GEMM(x) x
#else
#define RUN_GEMM(x)
#endif
#if defined(DUP_SCAN)
#define RUN_SCAN(x) x x
#elif !defined(SKIP_SCAN)
#define RUN_SCAN(x) x
#else
#define RUN_SCAN(x)
#endif
#ifndef SKIP_COMB
#define RUN_COMB(x) x
#else
#define RUN_COMB(x)
#endif
#ifndef SKIP_ACT
#define RUN_ACT(x) x
#else
#define RUN_ACT(x)
#endif
__global__ void __launch_bounds__(NTHR) fwd_megakernel(Params p_unused) {
    cg::grid_group grid = cg::this_grid();
    extern __shared__ __attribute__((aligned(16))) unsigned char smem[];
    float* ldsf = (float*)smem;
    bf16_t* ldsh = (bf16_t*)smem;
    KP kp = (KP)__builtin_amdgcn_kernarg_segment_ptr();
    volatile LAS3 unsigned* xst = (volatile LAS3 unsigned*)((LAS3 unsigned char*)smem + LDS_BYTES - 16);
    if (threadIdx.x == 0) { xst[0] = 0u; xst[1] = 0u; }
    __syncthreads();
    const XcdBarrier xb = xcd_barrier_post(kp, xst);

    RUN_MODS(phase_mods(kp, ldsf);)
    RUN_CONV(phase_convert(kp, 0, ldsf);)
    if (kp->ws == nullptr) grid.sync();
    xcd_barrier(xb);
#pragma unroll 1
    for (int l = 0; l < 2; ++l) {
        if (l == 0) { RUN_NORM(phase_norm(kp, 0, 0, 0, 0, 1, 0);) }
        else { RUN_CONV(convert_queue(kp, ldsf, 0, 0, 1088, 1 << 20); convert_queue(kp, ldsf, 1, 1088, 1616, 1 << 20);) RUN_NORM(phase_norm(kp, 1, 1, 1,   0 * 8 + 5, 1, 0);) }
        xcd_barrier(xb);
        {
            unsigned char* ws = fresh(kp)->ws;
            EpiInProj E{ws, l};
            Prog S = prog_plain((const bf16_t*)(ws + OFF_H), (const bf16_t*)(ws + OFF_WIN), 1024, 1024, 1024);
            S.pnmap = 1;
            RUN_GEMM(gemm_run(S, 32, 32, E, ldsh);)
        }
        xcd_barrier(xb);
        RUN_SCAN(phase_scan(kp, l, ldsf, l);)
#ifdef DUP_SCAN2
        phase_scan(kp, l, ldsf, l + 2);
#endif
        xcd_barrier(xb);
        RUN_COMB(phase_combine(kp);)
        xcd_barrier(xb);
        {
            unsigned char* ws = fresh(kp)->ws;
            Prog S = prog_plain((const bf16_t*)(ws + OFF_OA), (const bf16_t*)(ws + OFF_PA), 1024, 1024, 1024);
            S.A1 = (const bf16_t*)(ws + OFF_OB); S.B1 = (const bf16_t*)(ws + OFF_PB); S.lda1 = 2048; S.ldb1 = 2048; S.K1a = 512; S.K1b = 1536; S.mode = 1; S.ks = 2;
            EpiMerged E{ws};
            RUN_GEMM(gemm_run(S, 32, 4, E, ldsh);)
        }
        xcd_barrier(xb);
        {
            unsigned char* ws = fresh(kp)->ws;
            Prog S = prog_plain((const bf16_t*)(ws + OFF_MERGED), (const bf16_t*)(ws + OFF_WOUT), 1024, 1024, 1024);
            S.A1 = (const bf16_t*)(ws + OFF_MERGED) + (size_t)NTOK * 1024; S.ks = 2; S.bsame = 1;
            EpiBf E{(bf16_t*)(ws + OFF_P), (bf16_t*)(ws + OFF_P1), 1024};
            RUN_GEMM(gemm_run(S, 32, 4, E, ldsh);)
        }
        xcd_barrier(xb);
        RUN_NORM(phase_norm(kp, 1, 2 + l, l, l * 8 + 2, 4, 3);)
        xcd_barrier(xb);
        {
            KP pp = fresh(kp);
            unsigned char* ws = pp->ws;
            EpiUpConv E{ws, pp->w_conv + (size_t)l * 3 * DFF2, pp->b_conv + (size_t)l * DFF2};
            RUN_GEMM(gemm_run(prog_plain((const bf16_t*)(ws + OFF_H), (const bf16_t*)(ws + OFF_WUP), 1024, 1024, 1024), 32, 22, E, ldsh);)
        }
        if (l == 0 && (int)blockIdx.x + 2 * (int)gridDim.x >= 704) { RUN_CONV(convert_queue(kp, ldsf, 0, 0, 1088, 9);) }
        xcd_barrier(xb);
        {
            KP pp = fresh(kp);
            unsigned char* ws = pp->ws;
            Prog S = prog_plain((const bf16_t*)(ws + OFF_ACT), (const bf16_t*)(ws + OFF_WDN), DFF, DFF, DFF / 2);
            S.ks = 2;
            for (int u = blockIdx.x; u < 256; u += gridDim.x) {
                S.nM = 32; S.nN = 4; S.nwg = 128;
                int fpm, fpn; S.tile_of(u >> 1, fpm, fpn);
                conv_fixup(ws, pp->w_conv + (size_t)l * 3 * DFF2, pp->b_conv + (size_t)l * DFF2, fpm, (u & 1) * (DFF / 2));
            }
            EpiBf E{(bf16_t*)(ws + OFF_P), (bf16_t*)(ws + OFF_P1), 1024};
            RUN_GEMM(gemm_run(S, 32, 4, E, ldsh);)
        }
        xcd_barrier(xb);
    }
    RUN_NORM(phase_norm(kp, 2, 4, 1, 1 * 8 + 5, 0, 0);)
}

extern "C" void kernel_launch(void* const* d_in, const int* in_sizes, int n_in, void* d_out, int out_size, void* d_ws, size_t ws_size, hipStream_t stream) {
    static int grid_blocks = 0;
    if (!grid_blocks) {
        int dev = 0, cus = 0, per_cu = 0;
        hipGetDevice(&dev);
        hipDeviceGetAttribute(&cus, hipDeviceAttributeMultiprocessorCount, dev);
        if (hipFuncSetAttribute((const void*)fwd_megakernel, hipFuncAttributeMaxDynamicSharedMemorySize, LDS_BYTES) != hipSuccess) fprintf(stderr, "hipFuncSetAttribute failed\n");
        if (hipOccupancyMaxActiveBlocksPerMultiprocessor(&per_cu, (const void*)fwd_megakernel, NTHR, LDS_BYTES) != hipSuccess || per_cu < 1) fprintf(stderr, "occupancy query: %d per CU\n", per_cu);
        (void)hipGetLastError();
        grid_blocks = cus;
        if (ws_size < WS_END) fprintf(stderr, "workspace too small: %zu < %zu\n", ws_size, (size_t)WS_END);
    }
    Params p{};
    p.x_prompt = (const float*)d_in[0]; p.x_sample = (const float*)d_in[1]; p.state_hgrn = (const float*)d_in[2]; p.state_ret = (const float*)d_in[3];
    p.c = (const float*)d_in[4]; p.c_ctx = (const float*)d_in[5]; p.norm1 = (const float*)d_in[6]; p.norm2 = (const float*)d_in[7]; p.final_norm = (const float*)d_in[8];
    p.w_mod = (const float*)d_in[9]; p.b_mod = (const float*)d_in[10]; p.w_in = (const float*)d_in[11]; p.lb_raw = (const float*)d_in[12];
    p.p_a = (const float*)d_in[13]; p.p_b = (const float*)d_in[14]; p.w_out = (const float*)d_in[15]; p.w_up = (const float*)d_in[16];
    p.w_conv = (const float*)d_in[17]; p.b_conv = (const float*)d_in[18]; p.w_down = (const float*)d_in[19];
    p.out = (float*)d_out; p.ws = (unsigned char*)d_ws;
    (void)hipMemsetAsync((unsigned char*)d_ws + OFF_BAR, 0, 16384, stream);
    void* args[] = {&p};
    hipError_t e = hipLaunchCooperativeKernel((void*)fwd_megakernel, dim3(grid_blocks), dim3(NTHR), args, LDS_BYTES, stream);
    if (e != hipSuccess) fprintf(stderr, "cooperative launch failed: %s (grid %d)\n", hipGetErrorString(e), grid_blocks);
}
```

```cpp
#include <hip/hip_runtime.h>
#include <hip/hip_cooperative_groups.h>
#include <cstdio>
namespace cg = cooperative_groups;

typedef unsigned short bf16_t;
typedef short bf16x8 __attribute__((ext_vector_type(8)));
typedef float f32x4 __attribute__((ext_vector_type(4)));
typedef unsigned short u16x4 __attribute__((ext_vector_type(4)));
typedef unsigned short u16x8 __attribute__((ext_vector_type(8)));
typedef unsigned u32x4 __attribute__((ext_vector_type(4)));
typedef unsigned u32x2 __attribute__((ext_vector_type(2)));

#define DEV __device__ __forceinline__
#define LAS3 __attribute__((address_space(3)))

constexpr int D = 1024, NTOK = 8192, NCTX = 4096, INW = 13312, DFF = 2816, DFF2 = 5632;
constexpr int NTHR = 512;
constexpr int LDS_BYTES = 156 * 1024;
constexpr float EPS = 1e-6f;

constexpr size_t MB = 1024 * 1024;
constexpr size_t SZ_TOK_BF = (size_t)NTOK * 1024 * 2;
constexpr size_t OFF_WIN = 0;
constexpr size_t OFF_PA = OFF_WIN + (size_t)INW * 1024 * 2;
constexpr size_t OFF_PB = OFF_PA + (size_t)1024 * 1024 * 2;
constexpr size_t OFF_WOUT = OFF_PB + (size_t)1024 * 2048 * 2;
constexpr size_t OFF_WUP = OFF_WOUT + (size_t)1024 * 1024 * 2;
constexpr size_t OFF_WDN = OFF_WUP + (size_t)DFF2 * 1024 * 2;
constexpr size_t OFF_MODS = OFF_WDN + (size_t)1024 * DFF * 2;
constexpr size_t OFF_LB = OFF_MODS + 2 * 5 * 6144 * 4;
constexpr size_t OFF_ROPE = OFF_LB + 2 * 2 * 1024 * 4;
constexpr size_t OFF_H = ((OFF_ROPE + 64 * 64 * 2 * 4 + 4095) / 4096) * 4096;
constexpr size_t OFF_QA = OFF_H + SZ_TOK_BF;
constexpr size_t OFF_IA = OFF_QA + SZ_TOK_BF;
constexpr size_t OFF_GA = OFF_IA + SZ_TOK_BF;
constexpr size_t OFF_QB = OFF_GA + SZ_TOK_BF;
constexpr size_t OFF_KB = OFF_QB + SZ_TOK_BF;
constexpr size_t OFF_SGA = OFF_KB + SZ_TOK_BF;
constexpr size_t OFF_SGB = OFF_SGA + SZ_TOK_BF;
constexpr size_t OFF_VB = OFF_SGB + SZ_TOK_BF;
constexpr size_t OFF_GB = OFF_VB + 2 * SZ_TOK_BF;
constexpr size_t OFF_LFF = OFF_GB + 2 * SZ_TOK_BF;
constexpr size_t OFF_LFB = OFF_LFF + 2 * SZ_TOK_BF;
constexpr size_t OFF_OAF = OFF_LFB + 2 * SZ_TOK_BF;
constexpr size_t OFF_OAB = OFF_OAF + SZ_TOK_BF;
constexpr size_t OFF_OBF = OFF_OAB + SZ_TOK_BF;
constexpr size_t OFF_OBB = OFF_OBF + 2 * SZ_TOK_BF;
constexpr size_t OFF_BAR = OFF_OBB + 2 * SZ_TOK_BF;
constexpr size_t WS_END = OFF_BAR + 16384;
constexpr size_t OFF_OA = OFF_QA;
constexpr size_t OFF_OB = OFF_QB;
constexpr size_t OFF_MERGED = OFF_LFF;
constexpr size_t OFF_P = OFF_LFB;
constexpr size_t OFF_P1 = OFF_QA;
constexpr size_t OFF_UB = OFF_OAF;
constexpr size_t OFF_U = OFF_OAF;
constexpr size_t OFF_ACT = OFF_VB;

constexpr size_t OUT_Y = 0;
constexpr size_t OUT_SH = (size_t)NTOK * 1024;
constexpr size_t OUT_SR = OUT_SH + (size_t)16 * 2 * 2 * 8 * 128 * 128;

struct Params {
    const float *x_prompt, *x_sample, *state_hgrn, *state_ret, *c, *c_ctx, *norm1, *norm2, *final_norm, *w_mod, *b_mod, *w_in, *lb_raw, *p_a, *p_b, *w_out, *w_up,
        *w_conv, *b_conv, *w_down;
    float* out;
    unsigned char* ws;
};

typedef const __attribute__((address_space(4))) Params* KP;
DEV KP fresh(KP kp) { unsigned z; asm volatile("s_mov_b32 %0, 0" : "=s"(z)); return (KP)((const __attribute__((address_space(4))) char*)kp + z); }
DEV unsigned xb_add(unsigned* p, unsigned v) {
    unsigned old;
    asm volatile("global_atomic_add %0, %1, %2, off sc0\n\ts_waitcnt vmcnt(0)" : "=v"(old) : "v"(p), "v"(v) : "memory");
    return old;
}
DEV int otid() { int t = threadIdx.x; asm volatile("" : "+v"(t)); return t; }
typedef float f32x2n __attribute__((ext_vector_type(2)));
typedef __bf16 bf16x2n __attribute__((ext_vector_type(2)));
DEV unsigned pk2(float lo, float hi) { f32x2n v = {lo, hi}; return __builtin_bit_cast(unsigned, __builtin_convertvector(v, bf16x2n)); }
DEV bf16_t f2bf(float f) { return (bf16_t)(pk2(f, f) & 0xffffu); }
DEV void store_bf4(bf16_t* dst, f32x4 v) { u32x2 o; o[0] = pk2(v[0], v[1]); o[1] = pk2(v[2], v[3]); *(u32x2*)dst = o; }
DEV float bf2f(bf16_t b) { return __uint_as_float(((unsigned)b) << 16); }
DEV float sigmoidf_(float z) { return __builtin_amdgcn_rcpf(1.f + __expf(-z)); }
DEV float siluf_(float z) { return z * __builtin_amdgcn_rcpf(1.f + __expf(-z)); }
DEV float shfl_xor_l(float v, int o, int lane) { return __int_as_float(__builtin_amdgcn_ds_bpermute((lane ^ o) << 2, __float_as_int(v))); }
DEV float wave_sum(float v, int lane) {
#pragma unroll
    for (int o = 32; o > 0; o >>= 1) v += shfl_xor_l(v, o, lane);
    return v;
}
DEV int seq_row0(int s) { return s < 16 ? s * 256 : NCTX + (s - 16) * 1024; }
DEV int seq_len(int s) { return s < 16 ? 256 : 1024; }
DEV int row_modvec(int row) { return row < NCTX ? 0 : 1 + ((row - NCTX) >> 10); }

DEV void phase_mods(KP p, float* lds) {
    p = fresh(p);
    const int tid = otid();
    float* sv = lds;
    float* red = lds + 5 * 1024;
    for (int i = tid; i < 5 * 1024; i += NTHR) {
        int v = i >> 10, d = i & 1023;
        float cv = v == 0 ? p->c_ctx[d] : p->c[(v - 1) * 1024 + d];
        sv[i] = siluf_(cv);
    }
    __syncthreads();
    for (int it = blockIdx.x; it < 256; it += gridDim.x) {
        const int l = it >> 7, e0 = (it & 127) * 48;
        const int cq = tid % 12, r = tid / 12;
        f32x4 a0 = {0.f, 0.f, 0.f, 0.f}, a1 = a0, a2 = a0, a3 = a0, a4 = a0;
        if (r < 42) {
            const float* wp = p->w_mod + (size_t)l * 1024 * 6144 + e0 + 4 * cq;
#pragma unroll 4
            for (int d = r; d < 1024; d += 42) {
                const f32x4 w = __builtin_nontemporal_load((const f32x4*)(wp + (size_t)d * 6144));
                a0 += w * sv[d]; a1 += w * sv[1024 + d]; a2 += w * sv[2048 + d]; a3 += w * sv[3072 + d]; a4 += w * sv[4096 + d];
            }
            float* rp = red + (r * 12 + cq) * 20;
            *(f32x4*)(rp) = a0; *(f32x4*)(rp + 4) = a1; *(f32x4*)(rp + 8) = a2; *(f32x4*)(rp + 12) = a3; *(f32x4*)(rp + 16) = a4;
        }
        __syncthreads();
        if (tid < 240) {
            const int v = tid / 48, c = tid % 48;
            float sum = 0.f;
            for (int g = 0; g < 42; ++g) sum += red[(g * 12 + (c >> 2)) * 20 + v * 4 + (c & 3)];
            float* mods = (float*)(p->ws + OFF_MODS);
            mods[((size_t)l * 5 + v) * 6144 + e0 + c] = sum + p->b_mod[l * 6144 + e0 + c];
        }
        __syncthreads();
    }
    float* lb = (float*)(p->ws + OFF_LB);
    float* rope = (float*)(p->ws + OFF_ROPE);
    for (int i = blockIdx.x * NTHR + tid; i < 2048 + 4096; i += gridDim.x * NTHR) {
        if (i < 2048) {
            float r0 = p->lb_raw[i], r1 = p->lb_raw[2048 + i];
            lb[i] = 0.f;
            lb[2048 + i] = 1.f / (1.f + expf(r0 - r1));
        } else {
            int k = i - 2048, pos = k >> 6, j = k & 63;
            float inv = exp2f(-((float)j / 64.f) * 13.287712379549449f);
            float ang = (float)pos * inv;
            rope[2 * k] = __cosf(ang); rope[2 * k + 1] = __sinf(ang);
        }
    }
}

DEV int win_src_col(int n) {
    if (n < 5120 || n >= 7168) return n;
    const int e = n & 255, half = e >> 7, pp = e & 127, g = pp >> 3, r = pp & 7;
    const int orig = half * 128 + (r < 4 ? 4 * g + r : 64 + 4 * g + (r - 4));
    return (n - e) + orig;
}
DEV int wup_src_col(int n) {
    const int j = n >> 8, e = n & 255, q = e >> 3, r = e & 7;
    return r < 4 ? 128 * j + 4 * q + r : DFF + 128 * j + 4 * q + (r - 4);
}
DEV void convert_one(const float* W, int K, int N, bf16_t* Wt, int perm, int tile, float* lds) {
    const int nNt = N / 256;
    const int kt = tile / nNt, nt = tile % nNt;
    const int tid = otid();
    f32x4 v[8];
#pragma unroll
    for (int i = 0; i < 8; ++i) {
        const int idx = tid + NTHR * i, row = idx >> 6, c4 = idx & 63;
        const int srcc = perm == 2 ? (c4 < 32 ? 128 * nt + 4 * c4 : DFF + 128 * nt + 4 * (c4 - 32)) : nt * 256 + 4 * c4;
        v[i] = __builtin_nontemporal_load((const f32x4*)(W + (size_t)(kt * 64 + row) * N + srcc));
    }
#pragma unroll
    for (int i = 0; i < 8; ++i) {
        const int idx = tid + NTHR * i, row = idx >> 6, c4 = idx & 63;
        float* dp = lds + row * 257 + 4 * c4;
        dp[0] = v[i][0]; dp[1] = v[i][1]; dp[2] = v[i][2]; dp[3] = v[i][3];
    }
    __syncthreads();
    {
        const int k8 = tid & 7, nl = tid >> 3;
#pragma unroll
        for (int i = 0; i < 4; ++i) {
            const int n = nt * 256 + nl + 64 * i;
            const int sg = n & 255, pi = sg & 15;
            int np = (n & ~255) + 64 * ((sg >> 5) & 3) + 32 * (sg >> 7) + 8 * (pi >> 2) + 4 * ((sg >> 4) & 1) + (pi & 3);
            if (perm == 1 && n >= 1024 && n < 3072) np = (n & ~255) + 64 * ((sg >> 5) & 3) + 32 * (sg >> 7) + 16 * ((sg >> 4) & 1) + pi;
            int sc = (perm == 1 ? win_src_col(np) : np) - nt * 256;
            if (perm == 2) { const int e = np & 255, q = e >> 3, r = e & 7; sc = r < 4 ? 4 * q + r : 128 + 4 * q + (r - 4); }
            const float* sp = lds + (8 * k8) * 257 + sc;
            u32x4 o;
            o[0] = pk2(sp[0], sp[257]); o[1] = pk2(sp[2 * 257], sp[3 * 257]); o[2] = pk2(sp[4 * 257], sp[5 * 257]); o[3] = pk2(sp[6 * 257], sp[7 * 257]);
            *(u32x4*)(Wt + (size_t)n * K + kt * 64 + 8 * k8) = o;
        }
    }
    __syncthreads();
}
DEV void convert_tile(KP p, int l, int t, float* lds) {
    if (t < 832) convert_one(p->w_in + (size_t)l * 1024 * INW, 1024, INW, (bf16_t*)(p->ws + OFF_WIN), 1, t, lds);
    else if (t < 896) convert_one(p->p_a + (size_t)l * 1024 * 1024, 1024, 1024, (bf16_t*)(p->ws + OFF_PA), 0, t - 832, lds);
    else if (t < 1024) convert_one(p->p_b + (size_t)l * 2048 * 1024, 2048, 1024, (bf16_t*)(p->ws + OFF_PB), 0, t - 896, lds);
    else if (t < 1088) convert_one(p->w_out + (size_t)l * 1024 * 1024, 1024, 1024, (bf16_t*)(p->ws + OFF_WOUT), 0, t - 1024, lds);
    else if (t < 1440) convert_one(p->w_up + (size_t)l * 1024 * DFF2, 1024, DFF2, (bf16_t*)(p->ws + OFF_WUP), 2, t - 1088, lds);
    else convert_one(p->w_down + (size_t)l * DFF * 1024, DFF, 1024, (bf16_t*)(p->ws + OFF_WDN), 0, t - 1440, lds);
}
DEV void phase_convert(KP p, int l, float* lds) {
    p = fresh(p);
    for (int t = blockIdx.x; t < 1088; t += gridDim.x) convert_tile(p, l, t, lds);
}
DEV void convert_queue(KP p, float* lds, int cidx, int first, int last, int maxn) {
    p = fresh(p);
    unsigned* ctr = (unsigned*)(p->ws + OFF_BAR) + 3776 + 64 * cidx;
    volatile LAS3 unsigned* bc = (volatile LAS3 unsigned*)((LAS3 unsigned char*)lds + LDS_BYTES - 8);
    for (int k = 0; k < maxn; ++k) {
        __syncthreads();
        if (otid() == 0) *bc = xb_add(ctr, 1u);
        __syncthreads();
        const int t = first + (int)*bc;
        if (t >= last) break;
        convert_tile(p, 1, t, lds);
    }
    __syncthreads();
}

DEV void phase_norm(KP p, int mode, int nwsel, int lmod, int gate_idx, int sc_idx, int sh_idx) {
    p = fresh(p);
    const int tid = otid(), wid = tid >> 6, lane = tid & 63;
    const float* nw = nwsel < 2 ? p->norm1 + nwsel * 1024 : (nwsel < 4 ? p->norm2 + (nwsel - 2) * 1024 : p->final_norm);
    float* xbuf = p->out + OUT_Y;
    const bf16_t* P = (const bf16_t*)(p->ws + OFF_P);
    const bf16_t* P1 = (const bf16_t*)(p->ws + OFF_P1);
    const float* mods = (const float*)(p->ws + OFF_MODS);
    bf16_t* h = (bf16_t*)(p->ws + OFF_H);
    const float* xp = p->x_prompt; const float* xs = p->x_sample;
    const int stride = gridDim.x * 8;
    for (int row0 = blockIdx.x * 8 + wid; row0 < NTOK; row0 += 2 * stride) {
        f32x4 x[2][4], sc[2][4], sh[2][4], w[4];
        float ss[2] = {0.f, 0.f};
#pragma unroll
        for (int i = 0; i < 4; ++i) w[i] = *(const f32x4*)(nw + lane * 4 + 256 * i);
#pragma unroll
        for (int r = 0; r < 2; ++r) {
            const int row = row0 + r * stride;
            if (row < NTOK) {
                const int v = row_modvec(row);
#pragma unroll
                for (int i = 0; i < 4; ++i) {
                    const int c = lane * 4 + 256 * i;
                    if (mode == 0) {
                        const float* src = row < NCTX ? xp + (size_t)row * 1024 : xs + (size_t)(row - NCTX) * 1024;
                        x[r][i] = *(const f32x4*)(src + c);
                    } else {
                        x[r][i] = *(const f32x4*)(xbuf + (size_t)row * 1024 + c);
                        const u16x4 q0 = *(const u16x4*)(P + (size_t)row * 1024 + c), q1 = *(const u16x4*)(P1 + (size_t)row * 1024 + c);
                        const f32x4 g = *(const f32x4*)(mods + ((size_t)(gate_idx >> 3) * 5 + v) * 6144 + (gate_idx & 7) * 1024 + c);
                        f32x4 pv; pv[0] = bf2f(q0[0]) + bf2f(q1[0]); pv[1] = bf2f(q0[1]) + bf2f(q1[1]); pv[2] = bf2f(q0[2]) + bf2f(q1[2]); pv[3] = bf2f(q0[3]) + bf2f(q1[3]);
                        x[r][i] = x[r][i] + g * pv;
                    }
                    if (mode != 2) {
                        sc[r][i] = *(const f32x4*)(mods + ((size_t)lmod * 5 + v) * 6144 + sc_idx * 1024 + c);
                        sh[r][i] = *(const f32x4*)(mods + ((size_t)lmod * 5 + v) * 6144 + sh_idx * 1024 + c);
                    }
                    ss[r] += x[r][i][0] * x[r][i][0] + x[r][i][1] * x[r][i][1] + x[r][i][2] * x[r][i][2] + x[r][i][3] * x[r][i][3];
                }
            }
        }
        ss[0] = wave_sum(ss[0], lane); ss[1] = wave_sum(ss[1], lane);
#pragma unroll
        for (int r = 0; r < 2; ++r) {
            const int row = row0 + r * stride;
            if (row < NTOK) {
                const float rstd = rsqrtf(ss[r] * (1.f / 1024.f) + EPS);
#pragma unroll
                for (int i = 0; i < 4; ++i) {
                    const int c = lane * 4 + 256 * i;
                    if (mode == 2) {
                        *(f32x4*)(xbuf + (size_t)row * 1024 + c) = x[r][i] * rstd * w[i];
                    } else {
                        *(f32x4*)(xbuf + (size_t)row * 1024 + c) = x[r][i];
                        store_bf4(h + (size_t)row * 1024 + c, x[r][i] * rstd * w[i] * (sc[r][i] + 1.f) + sh[r][i]);
                    }
                }
            }
        }
    }
}

struct Seg { const bf16_t* A; const bf16_t* Bt; int lda, ldb, K; };

DEV void gemm_seg_simple(f32x4 (&acc)[2][2][4][2], const Seg& s, int pm, int pn, bf16_t* lds) {
    const int tid = otid(), wid = tid >> 6, lane = tid & 63, wr = wid >> 2, wc = wid & 3, fr = lane & 15, fq = lane >> 4;
    bf16_t* sA = lds;
    bf16_t* sB = lds + 256 * 40;
    const int lr = tid >> 2, lc = (tid & 3) * 8;
    for (int k0 = 0; k0 < s.K; k0 += 32) {
#pragma unroll
        for (int i = 0; i < 2; ++i) {
            const int r = lr + 128 * i;
            *(bf16x8*)(sA + r * 40 + lc) = *(const bf16x8*)(s.A + (size_t)(pm * 256 + r) * s.lda + k0 + lc);
            *(bf16x8*)(sB + r * 40 + lc) = *(const bf16x8*)(s.Bt + (size_t)(pn * 256 + r) * s.ldb + k0 + lc);
        }
        __syncthreads();
        bf16x8 bfr[2][2];
#pragma unroll
        for (int bj = 0; bj < 2; ++bj)
#pragma unroll
            for (int n = 0; n < 2; ++n) bfr[bj][n] = *(const bf16x8*)(sB + (128 * bj + 32 * wc + 16 * n + fr) * 40 + fq * 8);
#pragma unroll
        for (int ai = 0; ai < 2; ++ai)
#pragma unroll
            for (int m = 0; m < 4; ++m) {
                const bf16x8 af = *(const bf16x8*)(sA + (128 * ai + 64 * wr + 16 * m + fr) * 40 + fq * 8);
#pragma unroll
                for (int bj = 0; bj < 2; ++bj)
#pragma unroll
                    for (int n = 0; n < 2; ++n) acc[ai][bj][m][n] = __builtin_amdgcn_mfma_f32_16x16x32_bf16(bfr[bj][n], af, acc[ai][bj][m][n], 0, 0, 0);
            }
        __syncthreads();
    }
}

template <class F>
DEV void for_acc(f32x4 (&acc)[2][2][4][2], int pm, int pn, F f) {
    const int tid = otid(), wid = tid >> 6, lane = tid & 63, wr = wid >> 2, wc = wid & 3, fr = lane & 15, fq = lane >> 4;
#pragma unroll
    for (int a = 0; a < 2; ++a)
#pragma unroll
        for (int b = 0; b < 2; ++b)
#pragma unroll
            for (int m = 0; m < 4; ++m)
#pragma unroll
                for (int n = 0; n < 2; ++n) f(pm * 256 + 128 * a + 64 * wr + 16 * m + fr, pn * 256 + 64 * wc + 32 * b + 8 * fq + 4 * n, acc[a][b][m][n]);
}
template <class F>
DEV void for_acc2(f32x4 (&acc)[2][2][4][2], int pm, int pn, F f) {
    const int tid = otid(), wid = tid >> 6, lane = tid & 63, wr = wid >> 2, wc = wid & 3, fr = lane & 15, fq = lane >> 4;
#pragma unroll
    for (int a = 0; a < 2; ++a)
#pragma unroll
        for (int b = 0; b < 2; ++b)
#pragma unroll
            for (int m = 0; m < 4; ++m) f(pm * 256 + 128 * a + 64 * wr + 16 * m + fr, pn * 256 + 64 * wc + 32 * b + 8 * fq, acc[a][b][m][0], acc[a][b][m][1]);
}
DEV void zero_acc(f32x4 (&acc)[2][2][4][2]) {
#pragma unroll
    for (int a = 0; a < 2; ++a)
#pragma unroll
        for (int b = 0; b < 2; ++b)
#pragma unroll
            for (int m = 0; m < 4; ++m)
#pragma unroll
                for (int n = 0; n < 2; ++n) acc[a][b][m][n] = (f32x4){0.f, 0.f, 0.f, 0.f};
}

template <class Epi>
DEV void gemm_phase_simple(int nM, int nN, const Seg s0, const Seg s1, bool two, const Epi& E, bf16_t* lds) {
    for (int u = blockIdx.x; u < nM * nN; u += gridDim.x) {
        const int pm = u % nM, pn = u / nM;
        f32x4 acc[2][2][4][2];
        zero_acc(acc);
        gemm_seg_simple(acc, s0, pm, pn, lds);
        if (two) {
            E.mid(acc, pm, pn);
            gemm_seg_simple(acc, s1, pm, pn, lds);
        }
        E.fin(acc, pm, pn);
    }
}

#define LAS __attribute__((address_space(3)))
constexpr int HTB = 128 * 64 * 2;
DEV int lds_byte(int r, int c) { const int st = (r >> 4) * 2 + (c >> 5), rr = r & 15, cc = c & 31, ob = rr * 64 + cc * 2; return st * 1024 + (ob ^ (((ob >> 9) & 1) << 5)); }
DEV void stage_rc(int b, int& R, int& C) { const int st = b / 1024, sb = b % 1024, swz = sb ^ (((sb >> 9) & 1) << 5); R = (st >> 1) * 16 + swz / 64; C = (st & 1) * 32 + (swz % 64) / 2; }
struct Step { const char* A; const char* B; unsigned lda, ldb; int nt, pm, pn, kind, half; };
struct Prog {
    const bf16_t *A0, *B0, *A1, *B1; int lda0, ldb0, K0, lda1, ldb1, K1a, K1b, mode, ks, bsame, pnmap;
    int nM, nN, nwg, G, c;
    int j, stp;
    DEV void tile_of(int t, int& pm, int& pn) const {
        int wgid = t; { const int q = nwg / 8, r = nwg % 8, xcd = wgid % 8, off = wgid / 8; wgid = (xcd < r ? xcd * (q + 1) : r * (q + 1) + (xcd - r) * q) + off; }
        const int nig = 8 * nN, gid = wgid / nig, fm = gid * 8, gsz = (nM - fm) < 8 ? (nM - fm) : 8;
        pm = fm + ((wgid % nig) % gsz); pn = (wgid % nig) / gsz;
        if (pnmap == 1) pn = pn < 16 ? pn : pn + 4;
        else if (pnmap == 2) pn = pn < 4 ? 16 + pn : 32 + pn;
    }
    DEV bool next(Step& st) {
        const long L = (long)j * G + c;
        if (L >= (long)nwg * ks) return false;
        const int u = (int)L, tile = u / ks, half = u % ks;
        tile_of(tile, st.pm, st.pn); st.half = half;
        if (mode == 0) {
            st.lda = lda0 * 2; st.ldb = ldb0 * 2; st.nt = K0 / 64; st.kind = 0;
            const bf16_t* a = (half && A1) ? A1 : A0 + (size_t)half * K0 * (A1 ? 0 : 1);
            const bf16_t* bq = B0 + (size_t)half * K0 * (bsame ? 0 : 1);
            st.A = (const char*)a + (size_t)st.pm * 256 * st.lda; st.B = (const char*)bq + (size_t)st.pn * 256 * st.ldb;
            ++j;
        } else {
            if (half == 0 && stp == 0) {
                st.lda = lda0 * 2; st.ldb = ldb0 * 2; st.nt = K0 / 64; st.kind = 1;
                st.A = (const char*)A0 + (size_t)st.pm * 256 * st.lda; st.B = (const char*)B0 + (size_t)st.pn * 256 * st.ldb;
                stp = 1;
            } else {
                st.lda = lda1 * 2; st.ldb = ldb1 * 2; st.kind = 0;
                const int koff = half ? K1a : 0; st.nt = (half ? K1b : K1a) / 64;
                st.A = (const char*)(A1 + koff) + (size_t)st.pm * 256 * st.lda; st.B = (const char*)(B1 + koff) + (size_t)st.pn * 256 * st.ldb;
                stp = 0; ++j;
            }
        }
        return true;
    }
};
template <class Epi>
DEV void gemm_phase8(LAS unsigned char* lds, Prog& S, const Epi& E) {
    const int tid = otid(), wid = __builtin_amdgcn_readfirstlane(tid >> 6), lane = tid & 63, wr = wid >> 2, wc = wid & 3, fr = lane & 15, fq = lane >> 4;
    unsigned sR[2], sC2[2];
#pragma unroll
    for (int i = 0; i < 2; ++i) { int R, C; stage_rc(tid * 16 + i * 8192, R, C); sR[i] = (unsigned)R; sC2[i] = (unsigned)C * 2u; }
    const size_t kstep = 128;
    const unsigned ldsw = (unsigned)wid * 1024u;
    const int aoff = lds_byte(wr * 64 + fr, fq * 8), boff = lds_byte(wc * 32 + fr, fq * 8);
#define G8_SA(b, h) (((b) * 2 + (h)) * HTB)
#define G8_SB(b, h) ((4 + (b) * 2 + (h)) * HTB)
#define G8_STAGE(bufoff, gbase, ld) do { _Pragma("unroll") for (int _i = 0; _i < 2; ++_i) \
        __builtin_amdgcn_global_load_lds((const unsigned*)((const char*)(gbase) + (size_t)(sR[_i] * (ld) + sC2[_i])), (LAS unsigned*)(lds + (bufoff) + ldsw + _i * 8192), 16, 0, 0); } while (0)
#define G8_LDA(dst, b, h) do { _Pragma("unroll") for (int m = 0; m < 4; ++m) _Pragma("unroll") for (int k = 0; k < 2; ++k) dst[m][k] = *(const LAS bf16x8*)(lds + G8_SA(b, h) + aoff + m * 2048 + k * 1024); } while (0)
#define G8_LDB(dst, b, h) do { _Pragma("unroll") for (int n = 0; n < 2; ++n) _Pragma("unroll") for (int k = 0; k < 2; ++k) dst[n][k] = *(const LAS bf16x8*)(lds + G8_SB(b, h) + boff + n * 2048 + k * 1024); } while (0)
#define G8_MMA(ai, bj, At, Bt) do { __builtin_amdgcn_s_setprio(1); _Pragma("unroll") for (int m = 0; m < 4; ++m) _Pragma("unroll") for (int n = 0; n < 2; ++n) _Pragma("unroll") for (int k = 0; k < 2; ++k) \
        acc[ai][bj][m][n] = __builtin_amdgcn_mfma_f32_16x16x32_bf16(Bt[n][k], At[m][k], acc[ai][bj][m][n], 0, 0, 0); __builtin_amdgcn_s_setprio(0); } while (0)
#define G8_WAIT_V(n) asm volatile("s_waitcnt vmcnt(" #n ")" ::: "memory")
#define G8_WAIT_L(n) asm volatile("s_waitcnt lgkmcnt(" #n ")" ::: "memory")
#define G8_BAR __builtin_amdgcn_s_barrier()
#define G8_SCHED __builtin_amdgcn_sched_barrier(0)
    Step cur, nxt;
    if (!S.next(cur)) return;
    f32x4 acc[2][2][4][2];
    zero_acc(acc);
    bf16x8 At[4][2], B0[2][2], B1[2][2];
    {
        const char* cA = cur.A; const char* cB = cur.B; const unsigned la = cur.lda, lb = cur.ldb; const size_t hA = (size_t)128 * la, hB = (size_t)128 * lb;
        G8_STAGE(G8_SB(0, 0), cB, lb); G8_STAGE(G8_SA(0, 0), cA, la); G8_STAGE(G8_SB(0, 1), cB + hB, lb); G8_STAGE(G8_SA(0, 1), cA + hA, la);
        if (wr == 1) G8_BAR;
        G8_WAIT_V(4); G8_BAR;
        G8_STAGE(G8_SB(1, 0), cB + kstep, lb); G8_STAGE(G8_SA(1, 0), cA + kstep, la); G8_STAGE(G8_SB(1, 1), cB + hB + kstep, lb);
        G8_WAIT_V(6); G8_BAR;
    }
    for (;;) {
        const bool has_next = S.next(nxt);
        if (!has_next) nxt = cur;
        const char* cA = cur.A; const char* cB = cur.B; const unsigned la = cur.lda, lb = cur.ldb; const size_t hA = (size_t)128 * la, hB = (size_t)128 * lb;
        const int nt = cur.nt;
        for (int t = 0; t < nt; t += 2) {
            const bool last = (t == nt - 2);
            const char* a1 = cA + (size_t)(t + 1) * kstep;
            const char* a2 = last ? nxt.A : cA + (size_t)(t + 2) * kstep; const char* b2 = last ? nxt.B : cB + (size_t)(t + 2) * kstep;
            const unsigned la2 = last ? nxt.lda : la, lb2 = last ? nxt.ldb : lb; const size_t hA2 = (size_t)128 * la2, hB2 = (size_t)128 * lb2;
            const char* a3 = a2 + kstep; const char* b3 = b2 + kstep;
            G8_LDB(B0, 0, 0); G8_SCHED; G8_LDA(At, 0, 0); G8_STAGE(G8_SA(1, 1), a1 + hA, la);
            G8_WAIT_L(8); G8_BAR; G8_WAIT_L(0); G8_MMA(0, 0, At, B0); G8_BAR; G8_SCHED;
            G8_LDB(B1, 0, 1); G8_STAGE(G8_SB(0, 0), b2, lb2);
            G8_BAR; G8_WAIT_L(0); G8_MMA(0, 1, At, B1); G8_BAR;
            G8_LDA(At, 0, 1); G8_STAGE(G8_SA(0, 0), a2, la2);
            G8_BAR; G8_WAIT_L(0); G8_MMA(1, 0, At, B0); G8_BAR; G8_SCHED;
            G8_STAGE(G8_SB(0, 1), b2 + hB2, lb2);
            G8_WAIT_V(6); G8_BAR; G8_MMA(1, 1, At, B1); G8_BAR;
            G8_LDB(B0, 1, 0); G8_SCHED; G8_LDA(At, 1, 0); G8_STAGE(G8_SA(0, 1), a2 + hA2, la2);
            G8_WAIT_L(8); G8_BAR; G8_WAIT_L(0); G8_MMA(0, 0, At, B0); G8_BAR; G8_SCHED;
            G8_LDB(B1, 1, 1); G8_STAGE(G8_SB(1, 0), b3, lb2);
            G8_BAR; G8_WAIT_L(0); G8_MMA(0, 1, At, B1); G8_BAR;
            G8_LDA(At, 1, 1); G8_STAGE(G8_SA(1, 0), a3, la2);
            G8_BAR; G8_WAIT_L(0); G8_MMA(1, 0, At, B0); G8_BAR; G8_SCHED;
            G8_STAGE(G8_SB(1, 1), b3 + hB2, lb2);
            G8_WAIT_V(6); G8_BAR; G8_MMA(1, 1, At, B1); G8_BAR;
        }
        if (cur.kind == 1) E.mid(acc, cur.pm, cur.pn);
        else { E.fin(acc, cur.pm, cur.pn, cur.half); }
        if (!has_next) break;
        if (cur.kind == 0) zero_acc(acc);
        cur = nxt;
    }
    G8_WAIT_V(0);
    if (wr == 0) G8_BAR;
    G8_BAR;
#undef G8_SA
#undef G8_SB
#undef G8_STAGE
#undef G8_LDA
#undef G8_LDB
#undef G8_MMA
#undef G8_WAIT_V
#undef G8_WAIT_L
#undef G8_BAR
#undef G8_SCHED
}
template <class Epi>
DEV void gemm_run(Prog S, int nM, int nN, const Epi& E, bf16_t* ldsg) {
    S.nM = nM; S.nN = nN; S.nwg = nM * nN; S.G = gridDim.x; S.c = blockIdx.x; S.j = 0; S.stp = 0;
    gemm_phase8((LAS unsigned char*)ldsg, S, E);
}
template <class Epi>
DEV void gemm_one(Prog S, int nM, int nN, int unit, const Epi& E, bf16_t* ldsg) {
    S.nM = nM; S.nN = nN; S.nwg = nM * nN; S.G = 1 << 24; S.c = unit; S.j = 0; S.stp = 0;
    gemm_phase8((LAS unsigned char*)ldsg, S, E);
}
DEV Prog prog_plain(const bf16_t* A, const bf16_t* Bt, int lda, int ldb, int K) {
    Prog S; S.A0 = A; S.B0 = Bt; S.A1 = nullptr; S.B1 = nullptr; S.lda0 = lda; S.ldb0 = ldb; S.K0 = K; S.lda1 = 0; S.ldb1 = 0; S.K1a = 0; S.K1b = 0; S.mode = 0; S.ks = 1; S.bsame = 0; S.pnmap = 0; return S;
}


DEV u32x4 pack8(f32x4 v0, f32x4 v1) { u32x4 o; o[0] = pk2(v0[0], v0[1]); o[1] = pk2(v0[2], v0[3]); o[2] = pk2(v1[0], v1[1]); o[3] = pk2(v1[2], v1[3]); return o; }
DEV void stage_rows(bf16_t* dst, int ld, int rowbase, int colbase, u32x4 v0, u32x4 v1, int w, int fr, int fq, int lane) {
    extern __shared__ __attribute__((aligned(16))) unsigned char smem_x[];
    unsigned char* st = smem_x + 131072 + w * 2304;
    *(u32x4*)(st + fr * 144 + 16 * fq) = v0;
    *(u32x4*)(st + fr * 144 + 64 + 16 * fq) = v1;
    __builtin_amdgcn_wave_barrier();
    const int r = lane >> 3, pc = lane & 7;
    const u32x4 o0 = *(const u32x4*)(st + r * 144 + 16 * pc), o1 = *(const u32x4*)(st + (8 + r) * 144 + 16 * pc);
    *(u32x4*)(dst + (size_t)(rowbase + r) * ld + colbase + 8 * pc) = o0;
    *(u32x4*)(dst + (size_t)(rowbase + 8 + r) * ld + colbase + 8 * pc) = o1;
    __builtin_amdgcn_wave_barrier();
}
template <class G>
DEV void store_tile_rows(f32x4 (&acc)[2][2][4][2], int pm, bf16_t* dst, int ld, int coloff, G g) {
    const int tid = otid(), wid = tid >> 6, lane = tid & 63, wr = wid >> 2, wc = wid & 3, fr = lane & 15, fq = lane >> 4;
#pragma unroll
    for (int a = 0; a < 2; ++a)
#pragma unroll
        for (int m = 0; m < 4; ++m)
            stage_rows(dst, ld, pm * 256 + 128 * a + 64 * wr + 16 * m, coloff + 64 * wc, pack8(g(acc[a][0][m][0]), g(acc[a][0][m][1])), pack8(g(acc[a][1][m][0]), g(acc[a][1][m][1])), wid, fr, fq, lane);
}
DEV float logf_gate(float z, float lb) {
    const float e = __expf(-fabsf(z));
    const float r = __builtin_amdgcn_rcpf(1.f + e);
    const float sig = z >= 0.f ? r : e * r;
    return __builtin_amdgcn_logf(lb + (1.f - lb) * sig) * 0.6931471805599453f;
}

struct EpiInProj {
    unsigned char* ws; int l;
    DEV void mid(f32x4 (&)[2][2][4][2], int, int) const {}
    DEV void fin(f32x4 (&acc)[2][2][4][2], int pm, int pn, int half) const {
        const int col0 = pn * 256;
        unsigned char* w = ws; const int ll = l;
        if (col0 < 1024) { store_tile_rows(acc, pm, (bf16_t*)(w + OFF_QA), 1024, pn * 256 - 0, [](f32x4 v) { return v; }); }
        else if (col0 < 3072) {
            const int dir = col0 >= 2048;
            const float* lbp = (const float*)(w + OFF_LB) + (ll * 2 + dir) * 1024;
            float* dst = (float*)(w + (dir ? OFF_LFB : OFF_LFF));
            {
                const int tid = otid(), wid = tid >> 6, lane = tid & 63, wr = wid >> 2, wc = wid & 3, fr = lane & 15, fq = lane >> 4;
                const int cb = pn * 256 - 1024 - dir * 1024 + 64 * wc + 4 * fq;
                f32x4 lb4[2][2];
#pragma unroll
                for (int b = 0; b < 2; ++b)
#pragma unroll
                    for (int n = 0; n < 2; ++n) lb4[b][n] = *(const f32x4*)(lbp + cb + 32 * b + 16 * n);
#pragma unroll
                for (int a = 0; a < 2; ++a)
#pragma unroll
                    for (int m = 0; m < 4; ++m)
#pragma unroll
                        for (int b = 0; b < 2; ++b)
#pragma unroll
                            for (int n = 0; n < 2; ++n) {
                                const int row = pm * 256 + 128 * a + 64 * wr + 16 * m + fr;
                                f32x4 o;
#pragma unroll
                                for (int j = 0; j < 4; ++j) o[j] = logf_gate(acc[a][b][m][n][j], lb4[b][n][j]);
                                *(f32x4*)(dst + (size_t)row * 1024 + cb + 32 * b + 16 * n) = o;
                            }
            }
        }
        else if (col0 < 4096) { store_tile_rows(acc, pm, (bf16_t*)(w + OFF_IA), 1024, pn * 256 - 3072, [](f32x4 v) { return v; }); }
        else if (col0 < 5120) { store_tile_rows(acc, pm, (bf16_t*)(w + OFF_GA), 1024, pn * 256 - 4096, [](f32x4 v) { return v; }); }
        else if (col0 < 7168) {
            const int isk = col0 >= 6144;
            const float scale = isk ? 0.0625f : 1.f;
            bf16_t* dbase = (bf16_t*)(w + (isk ? OFF_KB : OFF_QB));
            const float* rope = (const float*)(w + OFF_ROPE);
            {
                const int tid = otid(), wid = tid >> 6, lane = tid & 63, wr = wid >> 2, wc = wid & 3, fr = lane & 15, fq = lane >> 4;
#pragma unroll
                for (int a = 0; a < 2; ++a) {
                    f32x4 cs0[2][4], cs1[2][4];
#pragma unroll
                    for (int b = 0; b < 2; ++b)
#pragma unroll
                        for (int m = 0; m < 4; ++m) {
                            const int row = pm * 256 + 128 * a + 64 * wr + 16 * m + fr;
                            const int g = 8 * (wc & 1) + 4 * b + fq;
                            const int t = (row - NCTX) & 1023, pos = (wc >> 1) ? (t & 63) : (t >> 6);
                            cs0[b][m] = *(const f32x4*)(rope + (pos * 64 + 4 * g) * 2); cs1[b][m] = *(const f32x4*)(rope + (pos * 64 + 4 * g) * 2 + 4);
                        }
#pragma unroll
                    for (int b = 0; b < 2; ++b)
#pragma unroll
                        for (int m = 0; m < 4; ++m) {
                            const int row = pm * 256 + 128 * a + 64 * wr + 16 * m + fr;
                            const int g = 8 * (wc & 1) + 4 * b + fq, hh = pn & 3;
                            const f32x4 x1 = acc[a][b][m][0] * scale, x2 = acc[a][b][m][1] * scale;
                            f32x4 o1 = x1, o2 = x2;
                            if (row >= NCTX) {
                                const f32x4 c0 = cs0[b][m], c1 = cs1[b][m];
                                o1[0] = x1[0] * c0[0] - x2[0] * c0[1]; o2[0] = x1[0] * c0[1] + x2[0] * c0[0];
                                o1[1] = x1[1] * c0[2] - x2[1] * c0[3]; o2[1] = x1[1] * c0[3] + x2[1] * c0[2];
                                o1[2] = x1[2] * c1[0] - x2[2] * c1[1]; o2[2] = x1[2] * c1[1] + x2[2] * c1[0];
                                o1[3] = x1[3] * c1[2] - x2[3] * c1[3]; o2[3] = x1[3] * c1[3] + x2[3] * c1[2];
                            }
                            bf16_t* dstp = dbase + (size_t)row * 1024 + hh * 256 + (wc >> 1) * 128 + 4 * g;
                            store_bf4(dstp, o1);
                            store_bf4(dstp + 64, o2);
                        }
                }
            }
        }
        else if (col0 < 9216) { store_tile_rows(acc, pm, (bf16_t*)(w + OFF_VB), 2048, pn * 256 - 7168, [](f32x4 v) { return v; }); }
        else if (col0 < 11264) { store_tile_rows(acc, pm, (bf16_t*)(w + OFF_GB), 2048, pn * 256 - 9216, [](f32x4 v) { return v; }); }
        else {
            const int isb = col0 >= 12288;
            bf16_t* dbase = (bf16_t*)(w + (isb ? OFF_SGB : OFF_SGA));
            store_tile_rows(acc, pm, dbase, 1024, pn * 256 - 11264 - isb * 1024, [](f32x4 v) { f32x4 o; o[0] = sigmoidf_(v[0]); o[1] = sigmoidf_(v[1]); o[2] = sigmoidf_(v[2]); o[3] = sigmoidf_(v[3]); return o; });
        }
    }
};
struct EpiMerged {
    unsigned char* ws;
    DEV void mid(f32x4 (&acc)[2][2][4][2], int pm, int pn) const {
        const bf16_t* sga = (const bf16_t*)(ws + OFF_SGA); const bf16_t* sgb = (const bf16_t*)(ws + OFF_SGB);
        for_acc(acc, pm, pn, [&](int row, int col, f32x4& v) {
            const u16x4 a = *(const u16x4*)(sga + (size_t)row * 1024 + col);
            const u16x4 b = *(const u16x4*)(sgb + (size_t)row * 1024 + col);
#pragma unroll
            for (int j = 0; j < 4; ++j) v[j] *= bf2f(a[j]) * __builtin_amdgcn_rcpf(fmaxf(bf2f(b[j]), 1e-30f));
        });
    }
    DEV void fin(f32x4 (&acc)[2][2][4][2], int pm, int pn, int half) const {
        const bf16_t* sgb = (const bf16_t*)(ws + OFF_SGB); bf16_t* mg = (bf16_t*)(ws + OFF_MERGED) + (size_t)half * NTOK * 1024;
        const int tid = otid(), wid = tid >> 6, lane = tid & 63, wr = wid >> 2, wc = wid & 3, fr = lane & 15, fq = lane >> 4;
        const int cb = pn * 256 + 64 * wc + 8 * fq;
#pragma unroll
        for (int a = 0; a < 2; ++a) {
            u16x8 gb[2][4];
#pragma unroll
            for (int b = 0; b < 2; ++b)
#pragma unroll
                for (int m = 0; m < 4; ++m) gb[b][m] = *(const u16x8*)(sgb + (size_t)(pm * 256 + 128 * a + 64 * wr + 16 * m + fr) * 1024 + cb + 32 * b);
#pragma unroll
            for (int b = 0; b < 2; ++b)
#pragma unroll
                for (int m = 0; m < 4; ++m) {
                    const size_t off = (size_t)(pm * 256 + 128 * a + 64 * wr + 16 * m + fr) * 1024 + cb + 32 * b;
                    u32x4 o;
#pragma unroll
                    for (int n = 0; n < 2; ++n) {
                        const f32x4 v = acc[a][b][m][n];
                        o[2 * n] = pk2(v[0] * fmaxf(bf2f(gb[b][m][4 * n]), 1e-30f), v[1] * fmaxf(bf2f(gb[b][m][4 * n + 1]), 1e-30f));
                        o[2 * n + 1] = pk2(v[2] * fmaxf(bf2f(gb[b][m][4 * n + 2]), 1e-30f), v[3] * fmaxf(bf2f(gb[b][m][4 * n + 3]), 1e-30f));
                    }
                    *(u32x4*)(mg + off) = o;
                }
        }
    }
};
struct EpiF32 {
    float* C; float* C1; int ldc;
    DEV void mid(f32x4 (&)[2][2][4][2], int, int) const {}
    DEV void fin(f32x4 (&acc)[2][2][4][2], int pm, int pn, int half) const {
        float* c = half ? C1 : C; const int ld = ldc;
        for_acc(acc, pm, pn, [&](int row, int col, f32x4& v) { *(f32x4*)(c + (size_t)row * ld + col) = v; });
    }
};
struct EpiBf {
    bf16_t* C; bf16_t* C1; int ldc;
    DEV void mid(f32x4 (&)[2][2][4][2], int, int) const {}
    DEV void fin(f32x4 (&acc)[2][2][4][2], int pm, int pn, int half) const {
        bf16_t* c = half ? C1 : C; const int ld = ldc;
        store_tile_rows(acc, pm, c, ld, pn * 256, [](f32x4 v) { return v; });
    }
};

#define ROR1(x)  __int_as_float(__builtin_amdgcn_update_dpp(0, __float_as_int(x), 0x121, 0xf, 0xf, false))
#define ROR15(x) __int_as_float(__builtin_amdgcn_update_dpp(0, __float_as_int(x), 0x12F, 0xf, 0xf, false))
struct EpiUpConv {
    unsigned char* ws; const float* wc_; const float* bc_;
    DEV void mid(f32x4 (&)[2][2][4][2], int, int) const {}
    DEV void fin(f32x4 (&acc)[2][2][4][2], int pm, int pn, int) const {
        const int tid = otid(), wid = tid >> 6, lane = tid & 63, wr = wid >> 2, wc = wid & 3, fr = lane & 15, fq = lane >> 4;
        bf16_t* act = (bf16_t*)(ws + OFF_ACT); bf16_t* ub = (bf16_t*)(ws + OFF_UB);
        const int ip = ((lane & 48) | ((fr + 15) & 15)) << 2, in = ((lane & 48) | ((fr + 1) & 15)) << 2;
#pragma unroll
        for (int b = 0; b < 2; ++b) {
            const int ch = pn * 128 + 4 * (8 * wc + 4 * b + fq);
            const f32x4 wa0 = *(const f32x4*)(wc_ + ch), wa1 = *(const f32x4*)(wc_ + DFF2 + ch), wa2 = *(const f32x4*)(wc_ + 2 * DFF2 + ch), ba = *(const f32x4*)(bc_ + ch);
            const f32x4 wg0 = *(const f32x4*)(wc_ + DFF + ch), wg1 = *(const f32x4*)(wc_ + DFF2 + DFF + ch), wg2 = *(const f32x4*)(wc_ + 2 * DFF2 + DFF + ch), bg = *(const f32x4*)(bc_ + DFF + ch);
#pragma unroll
            for (int a = 0; a < 2; ++a)
#pragma unroll
                for (int m = 0; m < 4; ++m) {
                    const int row = pm * 256 + 128 * a + 64 * wr + 16 * m + fr;
                    f32x4 pa, na, pg, ng;
#pragma unroll
                    for (int j = 0; j < 4; ++j) {
                        const float ca = acc[a][b][m][0][j], cg = acc[a][b][m][1][j];
                        const float sa_p = (m > 0 && fr == 15) ? acc[a][b][m > 0 ? m - 1 : 0][0][j] : ((m == 0 && fr == 15) ? 0.f : ca);
                        const float sg_p = (m > 0 && fr == 15) ? acc[a][b][m > 0 ? m - 1 : 0][1][j] : ((m == 0 && fr == 15) ? 0.f : cg);
                        const float sa_n = (m < 3 && fr == 0) ? acc[a][b][m < 3 ? m + 1 : 3][0][j] : ((m == 3 && fr == 0) ? 0.f : ca);
                        const float sg_n = (m < 3 && fr == 0) ? acc[a][b][m < 3 ? m + 1 : 3][1][j] : ((m == 3 && fr == 0) ? 0.f : cg);
                        pa[j] = ROR1(sa_p); pg[j] = ROR1(sg_p);
                        na[j] = ROR15(sa_n); ng[j] = ROR15(sg_n);
                    }
                    const f32x4 va = ba + wa0 * pa + wa1 * acc[a][b][m][0] + wa2 * na;
                    const f32x4 vg = bg + wg0 * pg + wg1 * acc[a][b][m][1] + wg2 * ng;
                    f32x4 o;
#pragma unroll
                    for (int j = 0; j < 4; ++j) o[j] = siluf_(vg[j]) * va[j];
                    store_bf4(act + (size_t)row * DFF + ch, o);
                    const int pos = row & 63;
                    if (pos < 2 || pos >= 62) {
                        bf16_t* up = ub + (size_t)((row >> 6) * 4 + (pos < 2 ? pos : pos - 60)) * DFF2;
                        store_bf4(up + ch, acc[a][b][m][0]);
                        store_bf4(up + DFF + ch, acc[a][b][m][1]);
                    }
                }
        }
    }
};
DEV void conv_fixup(unsigned char* ws, const float* wc_, const float* bc_, int pm, int c0) {
    const int tid = otid();
    bf16_t* act = (bf16_t*)(ws + OFF_ACT); const bf16_t* ub = (const bf16_t*)(ws + OFF_UB);
    for (int idx = tid; idx < 8 * 352; idx += NTHR) {
        const int ri = idx / 352, cq = idx % 352, ch = c0 + 4 * cq;
        const int R = pm * 256 + (ri >> 1) * 64 + ((ri & 1) ? 63 : 0);
        const int t = R < NCTX ? (R & 255) : ((R - NCTX) & 1023), T = R < NCTX ? 256 : 1024;
        const int blk = R >> 6;
        const bf16_t *rp, *rc, *rn;
        if (ri & 1) { rp = ub + (size_t)(blk * 4 + 2) * DFF2; rc = ub + (size_t)(blk * 4 + 3) * DFF2; rn = ub + (size_t)((blk + 1) * 4 + 0) * DFF2; }
        else { rp = ub + (size_t)((blk - 1) * 4 + 3) * DFF2; rc = ub + (size_t)(blk * 4 + 0) * DFF2; rn = ub + (size_t)(blk * 4 + 1) * DFF2; }
        const bool hp = t > 0, hn = t < T - 1;
        f32x4 va = *(const f32x4*)(bc_ + ch), vg = *(const f32x4*)(bc_ + DFF + ch);
        {
            const u16x4 xa = *(const u16x4*)(rc + ch), xg = *(const u16x4*)(rc + DFF + ch);
            const f32x4 wa = *(const f32x4*)(wc_ + DFF2 + ch), wg = *(const f32x4*)(wc_ + DFF2 + DFF + ch);
#pragma unroll
            for (int j = 0; j < 4; ++j) { va[j] += wa[j] * bf2f(xa[j]); vg[j] += wg[j] * bf2f(xg[j]); }
        }
        if (hp) {
            const u16x4 xa = *(const u16x4*)(rp + ch), xg = *(const u16x4*)(rp + DFF + ch);
            const f32x4 wa = *(const f32x4*)(wc_ + ch), wg = *(const f32x4*)(wc_ + DFF + ch);
#pragma unroll
            for (int j = 0; j < 4; ++j) { va[j] += wa[j] * bf2f(xa[j]); vg[j] += wg[j] * bf2f(xg[j]); }
        }
        if (hn) {
            const u16x4 xa = *(const u16x4*)(rn + ch), xg = *(const u16x4*)(rn + DFF + ch);
            const f32x4 wa = *(const f32x4*)(wc_ + 2 * DFF2 + ch), wg = *(const f32x4*)(wc_ + 2 * DFF2 + DFF + ch);
#pragma unroll
            for (int j = 0; j < 4; ++j) { va[j] += wa[j] * bf2f(xa[j]); vg[j] += wg[j] * bf2f(xg[j]); }
        }
        f32x4 o;
#pragma unroll
        for (int j = 0; j < 4; ++j) o[j] = siluf_(vg[j]) * va[j];
        store_bf4(act + (size_t)R * DFF + ch, o);
    }
    asm volatile("s_waitcnt vmcnt(0)" ::: "memory");
    __syncthreads();
}

DEV bf16x8 frag4(unsigned a, unsigned b, unsigned c, unsigned d) { u32x4 v; v[0] = a; v[1] = b; v[2] = c; v[3] = d; return __builtin_bit_cast(bf16x8, v); }
DEV bf16x8 ld16(const bf16_t* p) { return *(const bf16x8*)p; }
DEV u32x2 ld8(const bf16_t* p) { return *(const u32x2*)p; }
#define MFMA16(a, b, c) __builtin_amdgcn_mfma_f32_16x16x32_bf16(a, b, c, 0, 0, 0)

DEV void scan_ret_mfma(KP p, int l, int it, unsigned char* lds) {
    const int tid0 = otid();
    int s, head, dir, sl;
    if (it < 64) { s = 16 + (it >> 4); head = (it >> 2) & 3; dir = (it >> 1) & 1; sl = it & 1; }
    else { const int k = it - 64; s = k >> 4; head = (k >> 2) & 3; dir = (k >> 1) & 1; sl = k & 1; }
    const int row0 = seq_row0(s), T = seq_len(s);
    bf16_t* Qs = (bf16_t*)lds;
    bf16_t* Ks = Qs + 64 * 264;
    bf16_t* Kt = Ks + 64 * 264;
    bf16_t* Vt = Kt + 256 * 72;
    bf16_t* Ps = Vt + 256 * 72;
    float* gp = (float*)(Ps + 64 * 72);
    const bf16_t* qb = (const bf16_t*)(p->ws + OFF_QB);
    const bf16_t* kb = (const bf16_t*)(p->ws + OFF_KB);
    const bf16_t* vb = (const bf16_t*)(p->ws + OFF_VB);
    bf16_t* oo = (bf16_t*)(p->ws + (dir ? OFF_OBB : OFF_OBF));
    const float gamma = 1.f - exp2f(-(5.f + (dir ? 0.5f : 0.f)) - (float)head);
    const float lg2 = log2f(gamma);
    bf16x8 pq[4], pk[4], pv[4];
#define RET_ISSUE_QK(cc) do { const int tq_ = tid >> 5, c8_ = tid & 31; _Pragma("unroll") for (int i = 0; i < 4; ++i) { const int j = 4 * tq_ + i, tok = dir ? (T - 1 - ((cc) + j)) : ((cc) + j); \
        const size_t g = (size_t)(row0 + tok) * 1024 + head * 256 + c8_ * 8; pq[i] = *(const bf16x8*)(qb + g); pk[i] = *(const bf16x8*)(kb + g); } } while (0)
#define RET_ISSUE_V(cc) do { const int tq_ = tid >> 5, c8_ = tid & 31; _Pragma("unroll") for (int i = 0; i < 4; ++i) { const int j = 4 * tq_ + i, tok = dir ? (T - 1 - ((cc) + j)) : ((cc) + j); \
        pv[i] = *(const bf16x8*)(vb + (size_t)(row0 + tok) * 2048 + head * 512 + sl * 256 + 8 * c8_); } } while (0)
    { const int tid = tid0; RET_ISSUE_QK(0); RET_ISSUE_V(0); }
    __syncthreads();
    if (tid0 < 65) gp[tid0] = exp2f((float)tid0 * lg2);
    f32x4 S[16][2];
    {
        const int w = tid0 >> 6, fr = tid0 & 15, fq = (tid0 >> 4) & 3;
        if (s >= 16) {
            const float* st = p->state_ret + ((((size_t)(s - 16) * 2 + l) * 2 + dir) * 4 + head) * 256 * 512 + sl * 256 + 32 * w + 8 * (fr >> 2) + (fr & 3);
#pragma unroll
            for (int dt = 0; dt < 16; ++dt)
#pragma unroll
                for (int dvt = 0; dvt < 2; ++dvt)
#pragma unroll
                    for (int jj = 0; jj < 4; ++jj) S[dt][dvt][jj] = st[(size_t)(16 * dt + 4 * fq + jj) * 512 + 4 * dvt];
        } else {
#pragma unroll
            for (int dt = 0; dt < 16; ++dt) { S[dt][0] = (f32x4){0.f, 0.f, 0.f, 0.f}; S[dt][1] = (f32x4){0.f, 0.f, 0.f, 0.f}; }
        }
    }
    for (int c0 = 0; c0 < T; c0 += 64) {
        int tid = tid0; asm volatile("" : "+v"(tid));
        const int w = tid >> 6, lane = tid & 63, fr = lane & 15, fq = lane >> 4, tq = tid >> 5, c8 = tid & 31;
        __syncthreads();
        {
            const float g0 = gp[63 - 4 * tq], g1 = gp[62 - 4 * tq], g2 = gp[61 - 4 * tq], g3 = gp[60 - 4 * tq];
#pragma unroll
            for (int i = 0; i < 4; ++i) { *(bf16x8*)(Qs + (4 * tq + i) * 264 + c8 * 8) = pq[i]; *(bf16x8*)(Ks + (4 * tq + i) * 264 + c8 * 8) = pk[i]; }
            const int kpos = 8 * ((tq >> 1) ^ (c8 & 7)) + 4 * (tq & 1);
#pragma unroll
            for (int c = 0; c < 8; ++c) {
                u32x2 o;
                o[0] = pk2(bf2f((bf16_t)pk[0][c]) * g0, bf2f((bf16_t)pk[1][c]) * g1);
                o[1] = pk2(bf2f((bf16_t)pk[2][c]) * g2, bf2f((bf16_t)pk[3][c]) * g3);
                *(u32x2*)(Kt + (c8 * 8 + c) * 72 + kpos) = o;
                if (c & 1) __builtin_amdgcn_sched_barrier(0);
            }
#pragma unroll
            for (int c = 0; c < 8; ++c) {
                u32x2 o;
                o[0] = (unsigned)(bf16_t)pv[0][c] | ((unsigned)(bf16_t)pv[1][c] << 16);
                o[1] = (unsigned)(bf16_t)pv[2][c] | ((unsigned)(bf16_t)pv[3][c] << 16);
                *(u32x2*)(Vt + (c8 * 8 + c) * 72 + kpos) = o;
                if (c & 1) __builtin_amdgcn_sched_barrier(0);
            }
        }
        __syncthreads();
#pragma unroll
        for (int h = 0; h < 2; ++h) {
            const int idx = w + 8 * h, ti = idx >> 2, tj = idx & 3;
            f32x4 acc = (f32x4){0.f, 0.f, 0.f, 0.f};
            if (tj <= ti) {
#pragma unroll
                for (int ks = 0; ks < 8; ++ks)
                    acc = MFMA16(ld16(Ks + (16 * tj + fr) * 264 + 32 * ks + 8 * fq), ld16(Qs + (16 * ti + fr) * 264 + 32 * ks + 8 * fq), acc);
                const int i = 16 * ti + fr, j0 = 16 * tj + 4 * fq;
#pragma unroll
                for (int jj = 0; jj < 4; ++jj) { const int d = i - (j0 + jj); acc[jj] = d >= 0 ? acc[jj] * gp[d >= 0 ? d : 0] : 0.f; }
            }
            u32x2 o; o[0] = pk2(acc[0], acc[1]); o[1] = pk2(acc[2], acc[3]);
            *(u32x2*)(Ps + (16 * ti + fr) * 72 + 16 * tj + 4 * fq) = o;
        }
        __syncthreads();
        const int dv0 = 32 * w + 8 * (fr >> 2) + (fr & 3), dv1 = dv0 + 4;
        const int vsw0 = (dv0 >> 3) & 7, vsw1 = (dv1 >> 3) & 7;
        const bf16_t* vrow0 = Vt + dv0 * 72; const bf16_t* vrow1 = Vt + dv1 * 72;
        const bf16x8 vf00 = ld16(vrow0 + 8 * (fq ^ vsw0)), vf01 = ld16(vrow0 + 8 * ((4 + fq) ^ vsw0));
        const bf16x8 vf10 = ld16(vrow1 + 8 * (fq ^ vsw1)), vf11 = ld16(vrow1 + 8 * ((4 + fq) ^ vsw1));
        {
            f32x4 o[4][2];
#pragma unroll
            for (int tt = 0; tt < 4; ++tt) { o[tt][0] = (f32x4){0.f, 0.f, 0.f, 0.f}; o[tt][1] = (f32x4){0.f, 0.f, 0.f, 0.f}; }
            const bf16_t* qbase = Qs + fr * 264 + 4 * fq;
#pragma unroll
            for (int q = 0; q < 8; ++q) {
                const bf16x8 sf0 = frag4(pk2(S[2 * q][0][0], S[2 * q][0][1]), pk2(S[2 * q][0][2], S[2 * q][0][3]), pk2(S[2 * q + 1][0][0], S[2 * q + 1][0][1]), pk2(S[2 * q + 1][0][2], S[2 * q + 1][0][3]));
                const bf16x8 sf1 = frag4(pk2(S[2 * q][1][0], S[2 * q][1][1]), pk2(S[2 * q][1][2], S[2 * q][1][3]), pk2(S[2 * q + 1][1][0], S[2 * q + 1][1][1]), pk2(S[2 * q + 1][1][2], S[2 * q + 1][1][3]));
#pragma unroll
                for (int tt = 0; tt < 4; ++tt) {
                    const u32x2 b0 = ld8(qbase + 16 * tt * 264 + 32 * q), b1 = ld8(qbase + 16 * tt * 264 + 32 * q + 16);
                    const bf16x8 bq = frag4(b0[0], b0[1], b1[0], b1[1]);
                    o[tt][0] = MFMA16(sf0, bq, o[tt][0]);
                    o[tt][1] = MFMA16(sf1, bq, o[tt][1]);
                }
                __builtin_amdgcn_sched_barrier(0);
            }
            const bf16_t* pbase = Ps + fr * 72 + 8 * fq;
            const float* gbase = gp + fr + 1;
            const int i0 = c0 + fr;
#pragma unroll
            for (int tt = 0; tt < 4; ++tt) {
                const float sc = gbase[16 * tt];
                o[tt][0] = o[tt][0] * sc; o[tt][1] = o[tt][1] * sc;
                const bf16x8 p0 = ld16(pbase + 16 * tt * 72), p1 = ld16(pbase + 16 * tt * 72 + 32);
                o[tt][0] = MFMA16(vf00, p0, o[tt][0]); o[tt][0] = MFMA16(vf01, p1, o[tt][0]);
                o[tt][1] = MFMA16(vf10, p0, o[tt][1]); o[tt][1] = MFMA16(vf11, p1, o[tt][1]);
                const int pos = i0 + 16 * tt, tok = dir ? (T - 1 - pos) : pos;
                bf16_t* op = oo + (size_t)(row0 + tok) * 2048 + head * 512 + sl * 256 + 32 * w + 8 * fq;
                u32x4 ov; ov[0] = pk2(o[tt][0][0], o[tt][0][1]); ov[1] = pk2(o[tt][0][2], o[tt][0][3]); ov[2] = pk2(o[tt][1][0], o[tt][1][1]); ov[3] = pk2(o[tt][1][2], o[tt][1][3]);
                *(u32x4*)op = ov;
                __builtin_amdgcn_sched_barrier(0);
            }
        }
        __builtin_amdgcn_sched_barrier(0);
        if (c0 + 64 < T) RET_ISSUE_QK(c0 + 64);
        __builtin_amdgcn_sched_barrier(0);
        {
            const float g64 = gp[64];
            const bf16_t* kbase = Kt + fr * 72;
            const int kswb = (fr >> 3) & 1;
#pragma unroll
            for (int dt = 0; dt < 16; ++dt) {
                const int ksw = (2 * dt + kswb) & 7;
                const bf16x8 k0 = ld16(kbase + 16 * dt * 72 + 8 * (fq ^ ksw)), k1 = ld16(kbase + 16 * dt * 72 + 8 * ((4 + fq) ^ ksw));
                S[dt][0] = S[dt][0] * g64; S[dt][1] = S[dt][1] * g64;
                S[dt][0] = MFMA16(k0, vf00, S[dt][0]); S[dt][0] = MFMA16(k1, vf01, S[dt][0]);
                S[dt][1] = MFMA16(k0, vf10, S[dt][1]); S[dt][1] = MFMA16(k1, vf11, S[dt][1]);
                if (dt & 1) __builtin_amdgcn_sched_barrier(0);
            }
        }
        if (c0 + 64 < T) RET_ISSUE_V(c0 + 64);
    }
#undef RET_ISSUE_QK
#undef RET_ISSUE_V
    if (s < 16) {
        const int w = tid0 >> 6, fr = tid0 & 15, fq = (tid0 >> 4) & 3;
        float* st = p->out + OUT_SR + ((((size_t)s * 2 + l) * 2 + dir) * 4 + head) * 256 * 512 + sl * 256 + 32 * w + 8 * (fr >> 2) + (fr & 3);
#pragma unroll
        for (int dt = 0; dt < 16; ++dt)
#pragma unroll
            for (int dvt = 0; dvt < 2; ++dvt)
#pragma unroll
                for (int jj = 0; jj < 4; ++jj) st[(size_t)(16 * dt + 4 * fq + jj) * 512 + 4 * dvt] = S[dt][dvt][jj];
    }
}

DEV void scan_hgrn_mfma(KP p, int l, int it, unsigned char* lds) {
    const int tid = otid(), w = tid >> 6, lane = tid & 63, fr = lane & 15, fq = lane >> 4;
    int s, head, dir;
    if (it < 64) { s = 16 + (it >> 4); head = (it >> 1) & 7; dir = it & 1; }
    else { const int k = it - 64; s = k >> 4; head = (k >> 1) & 7; dir = k & 1; }
    const int row0 = seq_row0(s), T = seq_len(s);
    bf16_t* Qd = (bf16_t*)lds;
    bf16_t* Kn = Qd + 4 * 16 * 136;
    bf16_t* Kdt = Kn + 4 * 16 * 136;
    bf16_t* Vt = Kdt + 4 * 128 * 24;
    float* ae = (float*)(Vt + 4 * 128 * 24);
    const float* lfp = (const float*)(p->ws + (dir ? OFF_LFB : OFF_LFF));
    const bf16_t* qa = (const bf16_t*)(p->ws + OFF_QA);
    const bf16_t* ia = (const bf16_t*)(p->ws + OFF_IA);
    bf16_t* oo = (bf16_t*)(p->ws + (dir ? OFF_OAB : OFF_OAF));
    const int d = tid & 127, sub = tid >> 7;
    float plf[16]; bf16_t pqv[16], pvv[16];
#define HG_ISSUE(cc) do { _Pragma("unroll") for (int i = 0; i < 16; ++i) { const int pos = (cc) + 16 * sub + i, tok = dir ? (T - 1 - pos) : pos; \
        const size_t g = (size_t)(row0 + tok) * 1024 + head * 128 + d; plf[i] = lfp[g]; pqv[i] = qa[g]; pvv[i] = ia[g]; } } while (0)
    HG_ISSUE(0);
    f32x4 S[8];
    if (s >= 16) {
        const float* st = p->state_hgrn + ((((size_t)(s - 16) * 2 + l) * 2 + dir) * 8 + head) * 128 * 128 + 16 * w + fr;
#pragma unroll
        for (int dt = 0; dt < 8; ++dt)
#pragma unroll
            for (int jj = 0; jj < 4; ++jj) S[dt][jj] = st[(size_t)(16 * dt + 4 * fq + jj) * 128];
    } else {
#pragma unroll
        for (int dt = 0; dt < 8; ++dt) S[dt] = (f32x4){0.f, 0.f, 0.f, 0.f};
    }
    for (int c0 = 0; c0 < T; c0 += 64) {
        __syncthreads();
        {
            float cum = 0.f;
            float kn[16];
            unsigned vpk[8], kpk[8];
#pragma unroll
            for (int i = 0; i < 16; ++i) {
                const float lf = plf[i] * 1.4426950408889634f;
                cum += lf;
                const float k = 1.f - __builtin_amdgcn_exp2f(lf), q = bf2f(pqv[i]);
                const unsigned v = pvv[i];
                const float ec = __builtin_amdgcn_exp2f(fmaxf(cum, -100.f)), en = __builtin_amdgcn_rcpf(ec);
                Qd[(sub * 16 + i) * 136 + d] = f2bf(q * ec);
                kn[i] = k * en;
                Kn[(sub * 16 + i) * 136 + d] = f2bf(kn[i]);
                if (i & 1) vpk[i >> 1] |= v << 16; else vpk[i >> 1] = v;
            }
            const float aend = __builtin_amdgcn_exp2f(fmaxf(cum, -100.f));
            ae[sub * 128 + d] = aend;
#pragma unroll
            for (int i = 0; i < 8; ++i) kpk[i] = pk2(kn[2 * i] * aend, kn[2 * i + 1] * aend);
            u32x4 t0, t1;
            t0[0] = kpk[0]; t0[1] = kpk[1]; t0[2] = kpk[2]; t0[3] = kpk[3]; t1[0] = kpk[4]; t1[1] = kpk[5]; t1[2] = kpk[6]; t1[3] = kpk[7];
            *(u32x4*)(Kdt + (sub * 128 + d) * 24) = t0; *(u32x4*)(Kdt + (sub * 128 + d) * 24 + 8) = t1;
            t0[0] = vpk[0]; t0[1] = vpk[1]; t0[2] = vpk[2]; t0[3] = vpk[3]; t1[0] = vpk[4]; t1[1] = vpk[5]; t1[2] = vpk[6]; t1[3] = vpk[7];
            *(u32x4*)(Vt + (sub * 128 + d) * 24) = t0; *(u32x4*)(Vt + (sub * 128 + d) * 24 + 8) = t1;
        }
        if (c0 + 64 < T) HG_ISSUE(c0 + 64);
        __syncthreads();
#pragma unroll
        for (int sc = 0; sc < 4; ++sc) {
            const bf16_t* qd = Qd + sc * 16 * 136; const bf16_t* knp = Kn + sc * 16 * 136;
            const bf16_t* kdt = Kdt + sc * 128 * 24; const bf16_t* vt = Vt + sc * 128 * 24;
            f32x4 pa = (f32x4){0.f, 0.f, 0.f, 0.f};
#pragma unroll
            for (int ks = 0; ks < 4; ++ks) pa = MFMA16(ld16(knp + fr * 136 + 32 * ks + 8 * fq), ld16(qd + fr * 136 + 32 * ks + 8 * fq), pa);
#pragma unroll
            for (int jj = 0; jj < 4; ++jj) pa[jj] = (4 * fq + jj <= fr) ? pa[jj] : 0.f;
            const bf16x8 pb = frag4(pk2(pa[0], pa[1]), pk2(pa[2], pa[3]), 0u, 0u);
            f32x4 o = (f32x4){0.f, 0.f, 0.f, 0.f};
#pragma unroll
            for (int q = 0; q < 4; ++q) {
                const bf16x8 sf = frag4(pk2(S[2 * q][0], S[2 * q][1]), pk2(S[2 * q][2], S[2 * q][3]), pk2(S[2 * q + 1][0], S[2 * q + 1][1]), pk2(S[2 * q + 1][2], S[2 * q + 1][3]));
                const u32x2 b0 = ld8(qd + fr * 136 + 32 * q + 4 * fq), b1 = ld8(qd + fr * 136 + 32 * q + 16 + 4 * fq);
                o = MFMA16(sf, frag4(b0[0], b0[1], b1[0], b1[1]), o);
            }
            {
                const u32x2 va = ld8(vt + (16 * w + fr) * 24 + 4 * fq);
                o = MFMA16(frag4(va[0], va[1], 0u, 0u), pb, o);
            }
            {
                const int pos = c0 + 16 * sc + fr, tok = dir ? (T - 1 - pos) : pos;
                u32x2 ov; ov[0] = pk2(o[0], o[1]); ov[1] = pk2(o[2], o[3]);
                *(u32x2*)(oo + (size_t)(row0 + tok) * 1024 + head * 128 + 16 * w + 4 * fq) = ov;
            }
            bf16x8 vf = frag4(0u, 0u, 0u, 0u);
            if (fq < 2) vf = ld16(vt + (16 * w + fr) * 24 + 8 * fq);
#pragma unroll
            for (int dt = 0; dt < 8; ++dt) {
                const f32x4 a4 = *(const f32x4*)(ae + sc * 128 + 16 * dt + 4 * fq);
                S[dt] = S[dt] * a4;
                bf16x8 kf = frag4(0u, 0u, 0u, 0u);
                if (fq < 2) kf = ld16(kdt + (16 * dt + fr) * 24 + 8 * fq);
                S[dt] = MFMA16(kf, vf, S[dt]);
            }
        }
    }
#undef HG_ISSUE
    if (s < 16) {
        float* st = p->out + OUT_SH + ((((size_t)s * 2 + l) * 2 + dir) * 8 + head) * 128 * 128 + 16 * w + fr;
#pragma unroll
        for (int dt = 0; dt < 8; ++dt)
#pragma unroll
            for (int jj = 0; jj < 4; ++jj) st[(size_t)(16 * dt + 4 * fq + jj) * 128] = S[dt][jj];
    }
}

DEV void phase_scan(KP p, int l, float* lds, int qi) {
    p = fresh(p);
    unsigned* qctr = (unsigned*)(p->ws + OFF_BAR) + 3520 + 64 * qi;
    volatile LAS3 unsigned* bc = (volatile LAS3 unsigned*)((LAS3 unsigned char*)lds + LDS_BYTES - 8);
    for (;;) {
        __syncthreads();
        if (otid() == 0) *bc = xb_add(qctr, 1u);
        __syncthreads();
        const int it = (int)*bc;
        if (it >= 1412) break;
        if (it < 64) scan_ret_mfma(p, l, it, (unsigned char*)lds);
        else if (it < 128) scan_hgrn_mfma(p, l, it - 64, (unsigned char*)lds);
        else if (it < 768) {
            unsigned char* ws = p->ws;
            EpiInProj E{ws, l};
            Prog S = prog_plain((const bf16_t*)(ws + OFF_H), (const bf16_t*)(ws + OFF_WIN), 1024, 1024, 1024);
            S.pnmap = 2;
            gemm_one(S, 32, 20, it - 128, E, (bf16_t*)lds);
        }
        else if (it < 1024) scan_ret_mfma(p, l, it - 768 + 64, (unsigned char*)lds);
        else if (it < 1280) scan_hgrn_mfma(p, l, it - 1024 + 64, (unsigned char*)lds);
        else {
#pragma unroll 1
            for (int k = 0; k < 4; ++k) convert_tile(p, l, 1088 + 4 * (it - 1280) + k, lds);
        }
    }
    __syncthreads();
}

DEV void phase_combine(KP p) {
    p = fresh(p);
    const int tid = otid(), wid = tid >> 6, lane = tid & 63;
    const bf16_t* oaf = (const bf16_t*)(p->ws + OFF_OAF); const bf16_t* oab = (const bf16_t*)(p->ws + OFF_OAB);
    const bf16_t* obf = (const bf16_t*)(p->ws + OFF_OBF); const bf16_t* obb = (const bf16_t*)(p->ws + OFF_OBB);
    const bf16_t* ga = (const bf16_t*)(p->ws + OFF_GA); const bf16_t* gb = (const bf16_t*)(p->ws + OFF_GB);
    bf16_t* oa = (bf16_t*)(p->ws + OFF_OA); bf16_t* ob = (bf16_t*)(p->ws + OFF_OB);
    const int stride = gridDim.x * 8;
    for (int row0 = blockIdx.x * 8 + wid; row0 < NTOK; row0 += 2 * stride) {
        u16x8 af[2][2], ab[2][2], ag[2][2], bf[2][4], bb[2][4], bg[2][4];
#pragma unroll
        for (int r = 0; r < 2; ++r) {
            const int row = row0 + r * stride;
            if (row < NTOK) {
                const size_t ba = (size_t)row * 1024 + lane * 16, bbs = (size_t)row * 2048 + lane * 32;
#pragma unroll
                for (int h8 = 0; h8 < 2; ++h8) { af[r][h8] = *(const u16x8*)(oaf + ba + h8 * 8); ab[r][h8] = *(const u16x8*)(oab + ba + h8 * 8); ag[r][h8] = *(const u16x8*)(ga + ba + h8 * 8); }
#pragma unroll
                for (int h8 = 0; h8 < 4; ++h8) { bf[r][h8] = *(const u16x8*)(obf + bbs + h8 * 8); bb[r][h8] = *(const u16x8*)(obb + bbs + h8 * 8); bg[r][h8] = *(const u16x8*)(gb + bbs + h8 * 8); }
            }
        }
#pragma unroll
        for (int r = 0; r < 2; ++r) {
            const int row = row0 + r * stride;
            if (row < NTOK) {
                {
                    const size_t base = (size_t)row * 1024 + lane * 16;
                    float o[16]; float ss = 0.f;
#pragma unroll
                    for (int h8 = 0; h8 < 2; ++h8)
#pragma unroll
                        for (int i = 0; i < 8; ++i) { o[h8 * 8 + i] = bf2f(af[r][h8][i]) + bf2f(ab[r][h8][i]); ss += o[h8 * 8 + i] * o[h8 * 8 + i]; }
                    ss += shfl_xor_l(ss, 1, lane); ss += shfl_xor_l(ss, 2, lane); ss += shfl_xor_l(ss, 4, lane);
                    const float rstd = rsqrtf(ss * (1.f / 128.f) + EPS);
#pragma unroll
                    for (int h8 = 0; h8 < 2; ++h8) {
                        u32x4 rr;
#pragma unroll
                        for (int i = 0; i < 4; ++i) rr[i] = pk2(o[h8 * 8 + 2 * i] * rstd * siluf_(bf2f(ag[r][h8][2 * i])), o[h8 * 8 + 2 * i + 1] * rstd * siluf_(bf2f(ag[r][h8][2 * i + 1])));
                        *(u32x4*)(oa + base + h8 * 8) = rr;
                    }
                }
                {
                    const size_t base = (size_t)row * 2048 + lane * 32;
                    float o[32]; float ss = 0.f;
#pragma unroll
                    for (int h8 = 0; h8 < 4; ++h8)
#pragma unroll
                        for (int i = 0; i < 8; ++i) { o[h8 * 8 + i] = bf2f(bf[r][h8][i]) + bf2f(bb[r][h8][i]); ss += o[h8 * 8 + i] * o[h8 * 8 + i]; }
                    ss += shfl_xor_l(ss, 1, lane); ss += shfl_xor_l(ss, 2, lane); ss += shfl_xor_l(ss, 4, lane); ss += shfl_xor_l(ss, 8, lane);
                    const float rstd = rsqrtf(ss * (1.f / 512.f) + EPS);
#pragma unroll
                    for (int h8 = 0; h8 < 4; ++h8) {
                        u32x4 rr;
#pragma unroll
                        for (int i = 0; i < 4; ++i) rr[i] = pk2(o[h8 * 8 + 2 * i] * rstd * siluf_(bf2f(bg[r][h8][2 * i])), o[h8 * 8 + 2 * i + 1] * rstd * siluf_(bf2f(bg[r][h8][2 * i + 1])));
                        *(u32x4*)(ob + base + h8 * 8) = rr;
                    }
                }
            }
        }
    }
}

DEV void phase_convact(KP p, int l) {
    p = fresh(p);
    const bf16_t* u = (const bf16_t*)(p->ws + OFF_U);
    bf16_t* act = (bf16_t*)(p->ws + OFF_ACT);
    const float* wc = p->w_conv + (size_t)l * 3 * DFF2;
    const float* bc = p->b_conv + (size_t)l * DFF2;
    const int total = NTOK * (DFF / 8);
    for (int i = blockIdx.x * NTHR + otid(); i < total; i += gridDim.x * NTHR) {
        const int row = i / (DFF / 8), f = (i % (DFF / 8)) * 8;
        int t, T;
        if (row < NCTX) { t = row & 255; T = 256; } else { t = (row - NCTX) & 1023; T = 1024; }
        float ca[8], cgv[8];
#pragma unroll
        for (int k = 0; k < 8; ++k) { ca[k] = bc[f + k]; cgv[k] = bc[DFF + f + k]; }
#pragma unroll
        for (int dt = -1; dt <= 1; ++dt) {
            if (t + dt < 0 || t + dt >= T) continue;
            const bf16_t* ur = u + (size_t)(row + dt) * DFF2;
            const u16x8 ua = *(const u16x8*)(ur + f), ug = *(const u16x8*)(ur + DFF + f);
            const float* w = wc + (dt + 1) * DFF2;
#pragma unroll
            for (int k = 0; k < 8; ++k) { ca[k] += bf2f(ua[k]) * w[f + k]; cgv[k] += bf2f(ug[k]) * w[DFF + f + k]; }
        }
        u16x8 r;
#pragma unroll
        for (int k = 0; k < 8; ++k) r[k] = f2bf(siluf_(cgv[k]) * ca[k]);
        *(u16x8*)(act + (size_t)row * DFF + f) = r;
    }
}

#define XB_TMO      128
#define XB_XCNT(j)  (256  + 64 * (j))
#define XB_XSUB(j)  (1280 + 64 * (j))
#define XB_XGEN(j)  (2304 + 64 * (j))
#define XB_TOP      3328
#define XB_TOPGEN   3392
#define XCD_BAR_WORDS 3456
#define XB_SPIN_CAP (1u << 18)
DEV unsigned xb_ld(unsigned* p) { return __hip_atomic_load(p, __ATOMIC_RELAXED, __HIP_MEMORY_SCOPE_AGENT); }
DEV unsigned xb_xcc_id() { return (unsigned)__builtin_amdgcn_s_getreg((3 << 11) | 20) & 0xFu; }
#define XB_SPIN(cond, bar) do { unsigned _sp = 0; while (cond) { __builtin_amdgcn_s_sleep(1); \
    if ((++_sp & 255u) == 0u) { if (xb_ld(&(bar)[XB_TMO])) break; if (_sp > XB_SPIN_CAP) { (void)xb_add(&(bar)[XB_TMO], 1u); break; } } } } while (0)
struct XcdBarrier { KP kp; volatile LAS3 unsigned* st; };
DEV XcdBarrier xcd_barrier_post(KP kp, volatile LAS3 unsigned* st) {
    XcdBarrier b; b.kp = kp; b.st = st;
    unsigned* bar = (unsigned*)(kp->ws + OFF_BAR);
    if (threadIdx.x == 0) (void)xb_add(&bar[XB_XCNT(xb_xcc_id())], 1u);
    return b;
}
DEV void xcd_barrier_complete(unsigned* bar, unsigned x, unsigned& nloc, unsigned& nx) {
    const unsigned G = gridDim.x * gridDim.y * gridDim.z;
    unsigned sum, cnt, mine, sp = 0u;
    for (;;) {
        sum = 0u; cnt = 0u; mine = 0u;
#pragma unroll
        for (unsigned j = 0; j < 16; ++j) { const unsigned c = xb_ld(&bar[XB_XCNT(j)]); sum += c; cnt += (c > 0u) ? 1u : 0u; mine = (j == x) ? c : mine; }
        if (sum == G) break;
        __builtin_amdgcn_s_sleep(1);
        if ((++sp & 255u) == 0u) { if (xb_ld(&bar[XB_TMO])) break; if (sp > XB_SPIN_CAP) { (void)xb_add(&bar[XB_TMO], 1u); break; } }
    }
    nloc = mine > 0u ? mine : 1u; nx = cnt > 0u ? cnt : 1u;
}
DEV void xcd_barrier(const XcdBarrier& b) {
    asm volatile("s_waitcnt vmcnt(0)" ::: "memory");
    __syncthreads();
    if (threadIdx.x == 0) {
        unsigned* bar = (unsigned*)(fresh(b.kp)->ws + OFF_BAR);
        const unsigned bx = xb_xcc_id();
        __builtin_amdgcn_s_waitcnt(0);
        unsigned nloc = b.st[0], nx = b.st[1];
        if (nloc == 0u) { xcd_barrier_complete(bar, bx, nloc, nx); b.st[0] = nloc; b.st[1] = nx; }
        const unsigned old = xb_add(&bar[XB_XSUB(bx)], 1u);
        const unsigned gen = old / nloc;
        if (old + 1u == (gen + 1u) * nloc) {
            __builtin_amdgcn_fence(__ATOMIC_RELEASE, "agent");
            asm volatile("s_waitcnt vmcnt(0)" ::: "memory");
            const unsigned og = xb_add(&bar[XB_TOP], 1u);
            const unsigned tg = og / nx;
            if (og + 1u == (tg + 1u) * nx) xb_add(&bar[XB_TOPGEN], 1u);
            else XB_SPIN(xb_ld(&bar[XB_TOPGEN]) == tg, bar);
            __builtin_amdgcn_fence(__ATOMIC_ACQUIRE, "agent");
            xb_add(&bar[XB_XGEN(bx)], 1u);
            asm volatile("s_waitcnt vmcnt(0)" ::: "memory");
        } else {
            XB_SPIN(xb_ld(&bar[XB_XGEN(bx)]) == gen, bar);
            __builtin_amdgcn_fence(__ATOMIC_ACQUIRE, "agent");
            asm volatile("s_waitcnt vmcnt(0)" ::: "memory");
        }
    }
    __syncthreads();
}

#ifndef SKIP_MODS
#define RUN_MODS(x) x
#else
#define RUN_MODS(x)
#endif
#ifndef SKIP_CONV
#define RUN_CONV(x) x
#else
#define RUN_CONV(x)
#endif
#ifndef SKIP_NORM
#define RUN_NORM(x) x
#else
#define RUN_NORM(x)
#endif
#if defined(DUP_GEMM)
#define RUN_GEMM(x) x x
#elif !defined(SKIP_GEMM)
#define RUN_GEMM(x) x
#else
#define RUN_GEMM(x)
#endif
#if defined(DUP_SCAN)
#define RUN_SCAN(x) x x
#elif !defined(SKIP_SCAN)
#define RUN_SCAN(x) x
#else
#define RUN_SCAN(x)
#endif
#ifndef SKIP_COMB
#define RUN_COMB(x) x
#else
#define RUN_COMB(x)
#endif
#ifndef SKIP_ACT
#define RUN_ACT(x) x
#else
#define RUN_ACT(x)
#endif
__global__ void __launch_bounds__(NTHR) fwd_megakernel(Params p_unused) {
    cg::grid_group grid = cg::this_grid();
    extern __shared__ __attribute__((aligned(16))) unsigned char smem[];
    float* ldsf = (float*)smem;
    bf16_t* ldsh = (bf16_t*)smem;
    KP kp = (KP)__builtin_amdgcn_kernarg_segment_ptr();
    volatile LAS3 unsigned* xst = (volatile LAS3 unsigned*)((LAS3 unsigned char*)smem + LDS_BYTES - 16);
    if (threadIdx.x == 0) { xst[0] = 0u; xst[1] = 0u; }
    __syncthreads();
    const XcdBarrier xb = xcd_barrier_post(kp, xst);

    RUN_MODS(phase_mods(kp, ldsf);)
    RUN_CONV(phase_convert(kp, 0, ldsf);)
    if (kp->ws == nullptr) grid.sync();
    xcd_barrier(xb);
#pragma unroll 1
    for (int l = 0; l < 2; ++l) {
        if (l == 0) { RUN_NORM(phase_norm(kp, 0, 0, 0, 0, 1, 0);) }
        else { RUN_CONV(convert_queue(kp, ldsf, 0, 0, 1088, 1 << 20);) RUN_NORM(phase_norm(kp, 1, 1, 1,   0 * 8 + 5, 1, 0);) }
        xcd_barrier(xb);
        {
            unsigned char* ws = fresh(kp)->ws;
            EpiInProj E{ws, l};
            Prog S = prog_plain((const bf16_t*)(ws + OFF_H), (const bf16_t*)(ws + OFF_WIN), 1024, 1024, 1024);
            S.pnmap = 1;
            RUN_GEMM(gemm_run(S, 32, 32, E, ldsh);)
        }
        xcd_barrier(xb);
        RUN_SCAN(phase_scan(kp, l, ldsf, l);)
#ifdef DUP_SCAN2
        phase_scan(kp, l, ldsf, l + 2);
#endif
        xcd_barrier(xb);
        RUN_COMB(phase_combine(kp);)
        xcd_barrier(xb);
        {
            unsigned char* ws = fresh(kp)->ws;
            Prog S = prog_plain((const bf16_t*)(ws + OFF_OA), (const bf16_t*)(ws + OFF_PA), 1024, 1024, 1024);
            S.A1 = (const bf16_t*)(ws + OFF_OB); S.B1 = (const bf16_t*)(ws + OFF_PB); S.lda1 = 2048; S.ldb1 = 2048; S.K1a = 512; S.K1b = 1536; S.mode = 1; S.ks = 2;
            EpiMerged E{ws};
            RUN_GEMM(gemm_run(S, 32, 4, E, ldsh);)
        }
        xcd_barrier(xb);
        {
            unsigned char* ws = fresh(kp)->ws;
            Prog S = prog_plain((const bf16_t*)(ws + OFF_MERGED), (const bf16_t*)(ws + OFF_WOUT), 1024, 1024, 1024);
            S.A1 = (const bf16_t*)(ws + OFF_MERGED) + (size_t)NTOK * 1024; S.ks = 2; S.bsame = 1;
            EpiBf E{(bf16_t*)(ws + OFF_P), (bf16_t*)(ws + OFF_P1), 1024};
            RUN_GEMM(gemm_run(S, 32, 4, E, ldsh);)
        }
        xcd_barrier(xb);
        RUN_NORM(phase_norm(kp, 1, 2 + l, l, l * 8 + 2, 4, 3);)
        xcd_barrier(xb);
        {
            KP pp = fresh(kp);
            unsigned char* ws = pp->ws;
            EpiUpConv E{ws, pp->w_conv + (size_t)l * 3 * DFF2, pp->b_conv + (size_t)l * DFF2};
            RUN_GEMM(gemm_run(prog_plain((const bf16_t*)(ws + OFF_H), (const bf16_t*)(ws + OFF_WUP), 1024, 1024, 1024), 32, 22, E, ldsh);)
        }
        if (l == 0 && (int)blockIdx.x + 2 * (int)gridDim.x >= 704) { RUN_CONV(convert_queue(kp, ldsf, 0, 0, 1088, 9);) }
        xcd_barrier(xb);
        {
            KP pp = fresh(kp);
            unsigned char* ws = pp->ws;
            Prog S = prog_plain((const bf16_t*)(ws + OFF_ACT), (const bf16_t*)(ws + OFF_WDN), DFF, DFF, DFF / 2);
            S.ks = 2;
            for (int u = blockIdx.x; u < 256; u += gridDim.x) {
                S.nM = 32; S.nN = 4; S.nwg = 128;
                int fpm, fpn; S.tile_of(u >> 1, fpm, fpn);
                conv_fixup(ws, pp->w_conv + (size_t)l * 3 * DFF2, pp->b_conv + (size_t)l * DFF2, fpm, (u & 1) * (DFF / 2));
            }
            EpiBf E{(bf16_t*)(ws + OFF_P), (bf16_t*)(ws + OFF_P1), 1024};
            RUN_GEMM(gemm_run(S, 32, 4, E, ldsh);)
        }
        xcd_barrier(xb);
    }
    RUN_NORM(phase_norm(kp, 2, 4, 1, 1 * 8 + 5, 0, 0);)
}

extern "C" void kernel_launch(void* const* d_in, const int* in_sizes, int n_in, void* d_out, int out_size, void* d_ws, size_t ws_size, hipStream_t stream) {
    static int grid_blocks = 0;
    if (!grid_blocks) {
        int dev = 0, cus = 0, per_cu = 0;
        hipGetDevice(&dev);
        hipDeviceGetAttribute(&cus, hipDeviceAttributeMultiprocessorCount, dev);
        if (hipFuncSetAttribute((const void*)fwd_megakernel, hipFuncAttributeMaxDynamicSharedMemorySize, LDS_BYTES) != hipSuccess) fprintf(stderr, "hipFuncSetAttribute failed\n");
        if (hipOccupancyMaxActiveBlocksPerMultiprocessor(&per_cu, (const void*)fwd_megakernel, NTHR, LDS_BYTES) != hipSuccess || per_cu < 1) fprintf(stderr, "occupancy query: %d per CU\n", per_cu);
        (void)hipGetLastError();
        grid_blocks = cus;
        if (ws_size < WS_END) fprintf(stderr, "workspace too small: %zu < %zu\n", ws_size, (size_t)WS_END);
    }
    Params p{};
    p.x_prompt = (const float*)d_in[0]; p.x_sample = (const float*)d_in[1]; p.state_hgrn = (const float*)d_in[2]; p.state_ret = (const float*)d_in[3];
    p.c = (const float*)d_in[4]; p.c_ctx = (const float*)d_in[5]; p.norm1 = (const float*)d_in[6]; p.norm2 = (const float*)d_in[7]; p.final_norm = (const float*)d_in[8];
    p.w_mod = (const float*)d_in[9]; p.b_mod = (const float*)d_in[10]; p.w_in = (const float*)d_in[11]; p.lb_raw = (const float*)d_in[12];
    p.p_a = (const float*)d_in[13]; p.p_b = (const float*)d_in[14]; p.w_out = (const float*)d_in[15]; p.w_up = (const float*)d_in[16];
    p.w_conv = (const float*)d_in[17]; p.b_conv = (const float*)d_in[18]; p.w_down = (const float*)d_in[19];
    p.out = (float*)d_out; p.ws = (unsigned char*)d_ws;
    (void)hipMemsetAsync((unsigned char*)d_ws + OFF_BAR, 0, 16384, stream);
    void* args[] = {&p};
    hipError_t e = hipLaunchCooperativeKernel((void*)fwd_megakernel, dim3(grid_blocks), dim3(NTHR), args, LDS_BYTES, stream);
    if (e != hipSuccess) fprintf(stderr, "cooperative launch failed: %s (grid %d)\n", hipGetErrorString(e), grid_blocks);
}
```

```cpp
#include <hip/hip_runtime.h>
#include <hip/hip_cooperative_groups.h>
#include <cstdio>
namespace cg = cooperative_groups;

typedef unsigned short bf16_t;
typedef short bf16x8 __attribute__((ext_vector_type(8)));
typedef float f32x4 __attribute__((ext_vector_type(4)));
typedef unsigned short u16x4 __attribute__((ext_vector_type(4)));
typedef unsigned short u16x8 __attribute__((ext_vector_type(8)));
typedef unsigned u32x4 __attribute__((ext_vector_type(4)));
typedef unsigned u32x2 __attribute__((ext_vector_type(2)));

#define DEV __device__ __forceinline__
#define LAS3 __attribute__((address_space(3)))

constexpr int D = 1024, NTOK = 8192, NCTX = 4096, INW = 13312, DFF = 2816, DFF2 = 5632;
constexpr int NTHR = 512;
constexpr int LDS_BYTES = 156 * 1024;
constexpr float EPS = 1e-6f;

constexpr size_t MB = 1024 * 1024;
constexpr size_t SZ_TOK_BF = (size_t)NTOK * 1024 * 2;
constexpr size_t OFF_WIN = 0;
constexpr size_t OFF_PA = OFF_WIN + (size_t)INW * 1024 * 2;
constexpr size_t OFF_PB = OFF_PA + (size_t)1024 * 1024 * 2;
constexpr size_t OFF_WOUT = OFF_PB + (size_t)1024 * 2048 * 2;
constexpr size_t OFF_WUP = OFF_WOUT + (size_t)1024 * 1024 * 2;
constexpr size_t OFF_WDN = OFF_WUP + (size_t)DFF2 * 1024 * 2;
constexpr size_t OFF_MODS = OFF_WDN + (size_t)1024 * DFF * 2;
constexpr size_t OFF_LB = OFF_MODS + 2 * 5 * 6144 * 4;
constexpr size_t OFF_ROPE = OFF_LB + 2 * 2 * 1024 * 4;
constexpr size_t OFF_H = ((OFF_ROPE + 64 * 64 * 2 * 4 + 4095) / 4096) * 4096;
constexpr size_t OFF_QA = OFF_H + SZ_TOK_BF;
constexpr size_t OFF_IA = OFF_QA + SZ_TOK_BF;
constexpr size_t OFF_GA = OFF_IA + SZ_TOK_BF;
constexpr size_t OFF_QB = OFF_GA + SZ_TOK_BF;
constexpr size_t OFF_KB = OFF_QB + SZ_TOK_BF;
constexpr size_t OFF_SGA = OFF_KB + SZ_TOK_BF;
constexpr size_t OFF_SGB = OFF_SGA + SZ_TOK_BF;
constexpr size_t OFF_VB = OFF_SGB + SZ_TOK_BF;
constexpr size_t OFF_GB = OFF_VB + 2 * SZ_TOK_BF;
constexpr size_t OFF_LFF = OFF_GB + 2 * SZ_TOK_BF;
constexpr size_t OFF_LFB = OFF_LFF + 2 * SZ_TOK_BF;
constexpr size_t OFF_OAF = OFF_LFB + 2 * SZ_TOK_BF;
constexpr size_t OFF_OAB = OFF_OAF + SZ_TOK_BF;
constexpr size_t OFF_OBF = OFF_OAB + SZ_TOK_BF;
constexpr size_t OFF_OBB = OFF_OBF + 2 * SZ_TOK_BF;
constexpr size_t OFF_BAR = OFF_OBB + 2 * SZ_TOK_BF;
constexpr size_t WS_END = OFF_BAR + 16384;
constexpr size_t OFF_OA = OFF_QA;
constexpr size_t OFF_OB = OFF_QB;
constexpr size_t OFF_MERGED = OFF_LFF;
constexpr size_t OFF_P = OFF_LFB;
constexpr size_t OFF_P1 = OFF_QA;
constexpr size_t OFF_UB = OFF_OAF;
constexpr size_t OFF_U = OFF_OAF;
constexpr size_t OFF_ACT = OFF_VB;

constexpr size_t OUT_Y = 0;
constexpr size_t OUT_SH = (size_t)NTOK * 1024;
constexpr size_t OUT_SR = OUT_SH + (size_t)16 * 2 * 2 * 8 * 128 * 128;

struct Params {
    const float *x_prompt, *x_sample, *state_hgrn, *state_ret, *c, *c_ctx, *norm1, *norm2, *final_norm, *w_mod, *b_mod, *w_in, *lb_raw, *p_a, *p_b, *w_out, *w_up,
        *w_conv, *b_conv, *w_down;
    float* out;
    unsigned char* ws;
};

typedef const __attribute__((address_space(4))) Params* KP;
DEV KP fresh(KP kp) { unsigned z; asm volatile("s_mov_b32 %0, 0" : "=s"(z)); return (KP)((const __attribute__((address_space(4))) char*)kp + z); }
DEV unsigned xb_add(unsigned* p, unsigned v) {
    unsigned old;
    asm volatile("global_atomic_add %0, %1, %2, off sc0\n\ts_waitcnt vmcnt(0)" : "=v"(old) : "v"(p), "v"(v) : "memory");
    return old;
}
DEV int otid() { int t = threadIdx.x; asm volatile("" : "+v"(t)); return t; }
typedef float f32x2n __attribute__((ext_vector_type(2)));
typedef __bf16 bf16x2n __attribute__((ext_vector_type(2)));
DEV unsigned pk2(float lo, float hi) { f32x2n v = {lo, hi}; return __builtin_bit_cast(unsigned, __builtin_convertvector(v, bf16x2n)); }
DEV bf16_t f2bf(float f) { return (bf16_t)(pk2(f, f) & 0xffffu); }
DEV void store_bf4(bf16_t* dst, f32x4 v) { u32x2 o; o[0] = pk2(v[0], v[1]); o[1] = pk2(v[2], v[3]); *(u32x2*)dst = o; }
DEV float bf2f(bf16_t b) { return __uint_as_float(((unsigned)b) << 16); }
DEV float sigmoidf_(float z) { return __builtin_amdgcn_rcpf(1.f + __expf(-z)); }
DEV float siluf_(float z) { return z * __builtin_amdgcn_rcpf(1.f + __expf(-z)); }
DEV float shfl_xor_l(float v, int o, int lane) { return __int_as_float(__builtin_amdgcn_ds_bpermute((lane ^ o) << 2, __float_as_int(v))); }
DEV float wave_sum(float v, int lane) {
#pragma unroll
    for (int o = 32; o > 0; o >>= 1) v += shfl_xor_l(v, o, lane);
    return v;
}
DEV int seq_row0(int s) { return s < 16 ? s * 256 : NCTX + (s - 16) * 1024; }
DEV int seq_len(int s) { return s < 16 ? 256 : 1024; }
DEV int row_modvec(int row) { return row < NCTX ? 0 : 1 + ((row - NCTX) >> 10); }

DEV void phase_mods(KP p, float* lds) {
    p = fresh(p);
    const int tid = otid();
    float* sv = lds;
    float* red = lds + 5 * 1024;
    for (int i = tid; i < 5 * 1024; i += NTHR) {
        int v = i >> 10, d = i & 1023;
        float cv = v == 0 ? p->c_ctx[d] : p->c[(v - 1) * 1024 + d];
        sv[i] = siluf_(cv);
    }
    __syncthreads();
    for (int it = blockIdx.x; it < 256; it += gridDim.x) {
        const int l = it >> 7, e0 = (it & 127) * 48;
        const int cq = tid % 12, r = tid / 12;
        f32x4 a0 = {0.f, 0.f, 0.f, 0.f}, a1 = a0, a2 = a0, a3 = a0, a4 = a0;
        if (r < 42) {
            const float* wp = p->w_mod + (size_t)l * 1024 * 6144 + e0 + 4 * cq;
#pragma unroll 4
            for (int d = r; d < 1024; d += 42) {
                const f32x4 w = __builtin_nontemporal_load((const f32x4*)(wp + (size_t)d * 6144));
                a0 += w * sv[d]; a1 += w * sv[1024 + d]; a2 += w * sv[2048 + d]; a3 += w * sv[3072 + d]; a4 += w * sv[4096 + d];
            }
            float* rp = red + (r * 12 + cq) * 20;
            *(f32x4*)(rp) = a0; *(f32x4*)(rp + 4) = a1; *(f32x4*)(rp + 8) = a2; *(f32x4*)(rp + 12) = a3; *(f32x4*)(rp + 16) = a4;
        }
        __syncthreads();
        if (tid < 240) {
            const int v = tid / 48, c = tid % 48;
            float sum = 0.f;
            for (int g = 0; g < 42; ++g) sum += red[(g * 12 + (c >> 2)) * 20 + v * 4 + (c & 3)];
            float* mods = (float*)(p->ws + OFF_MODS);
            mods[((size_t)l * 5 + v) * 6144 + e0 + c] = sum + p->b_mod[l * 6144 + e0 + c];
        }
        __syncthreads();
    }
    float* lb = (float*)(p->ws + OFF_LB);
    float* rope = (float*)(p->ws + OFF_ROPE);
    for (int i = blockIdx.x * NTHR + tid; i < 2048 + 4096; i += gridDim.x * NTHR) {
        if (i < 2048) {
            float r0 = p->lb_raw[i], r1 = p->lb_raw[2048 + i];
            lb[i] = 0.f;
            lb[2048 + i] = 1.f / (1.f + expf(r0 - r1));
        } else {
            int k = i - 2048, pos = k >> 6, j = k & 63;
            float inv = exp2f(-((float)j / 64.f) * 13.287712379549449f);
            float ang = (float)pos * inv;
            rope[2 * k] = __cosf(ang); rope[2 * k + 1] = __sinf(ang);
        }
    }
}

DEV int win_src_col(int n) {
    if (n < 5120 || n >= 7168) return n;
    const int e = n & 255, half = e >> 7, pp = e & 127, g = pp >> 3, r = pp & 7;
    const int orig = half * 128 + (r < 4 ? 4 * g + r : 64 + 4 * g + (r - 4));
    return (n - e) + orig;
}
DEV int wup_src_col(int n) {
    const int j = n >> 8, e = n & 255, q = e >> 3, r = e & 7;
    return r < 4 ? 128 * j + 4 * q + r : DFF + 128 * j + 4 * q + (r - 4);
}
DEV void convert_one(const float* W, int K, int N, bf16_t* Wt, int perm, int tile, float* lds) {
    const int nNt = N / 256;
    const int kt = tile / nNt, nt = tile % nNt;
    const int tid = otid();
    f32x4 v[8];
#pragma unroll
    for (int i = 0; i < 8; ++i) {
        const int idx = tid + NTHR * i, row = idx >> 6, c4 = idx & 63;
        const int srcc = perm == 2 ? (c4 < 32 ? 128 * nt + 4 * c4 : DFF + 128 * nt + 4 * (c4 - 32)) : nt * 256 + 4 * c4;
        v[i] = __builtin_nontemporal_load((const f32x4*)(W + (size_t)(kt * 64 + row) * N + srcc));
    }
#pragma unroll
    for (int i = 0; i < 8; ++i) {
        const int idx = tid + NTHR * i, row = idx >> 6, c4 = idx & 63;
        float* dp = lds + row * 257 + 4 * c4;
        dp[0] = v[i][0]; dp[1] = v[i][1]; dp[2] = v[i][2]; dp[3] = v[i][3];
    }
    __syncthreads();
    {
        const int k8 = tid & 7, nl = tid >> 3;
#pragma unroll
        for (int i = 0; i < 4; ++i) {
            const int n = nt * 256 + nl + 64 * i;
            const int sg = n & 255, pi = sg & 15;
            int np = (n & ~255) + 64 * ((sg >> 5) & 3) + 32 * (sg >> 7) + 8 * (pi >> 2) + 4 * ((sg >> 4) & 1) + (pi & 3);
            if (perm == 1 && n >= 1024 && n < 3072) np = (n & ~255) + 64 * ((sg >> 5) & 3) + 32 * (sg >> 7) + 16 * ((sg >> 4) & 1) + pi;
            int sc = (perm == 1 ? win_src_col(np) : np) - nt * 256;
            if (perm == 2) { const int e = np & 255, q = e >> 3, r = e & 7; sc = r < 4 ? 4 * q + r : 128 + 4 * q + (r - 4); }
            const float* sp = lds + (8 * k8) * 257 + sc;
            u32x4 o;
            o[0] = pk2(sp[0], sp[257]); o[1] = pk2(sp[2 * 257], sp[3 * 257]); o[2] = pk2(sp[4 * 257], sp[5 * 257]); o[3] = pk2(sp[6 * 257], sp[7 * 257]);
            *(u32x4*)(Wt + (size_t)n * K + kt * 64 + 8 * k8) = o;
        }
    }
    __syncthreads();
}
DEV void convert_tile(KP p, int l, int t, float* lds) {
    if (t < 832) convert_one(p->w_in + (size_t)l * 1024 * INW, 1024, INW, (bf16_t*)(p->ws + OFF_WIN), 1, t, lds);
    else if (t < 896) convert_one(p->p_a + (size_t)l * 1024 * 1024, 1024, 1024, (bf16_t*)(p->ws + OFF_PA), 0, t - 832, lds);
    else if (t < 1024) convert_one(p->p_b + (size_t)l * 2048 * 1024, 2048, 1024, (bf16_t*)(p->ws + OFF_PB), 0, t - 896, lds);
    else if (t < 1088) convert_one(p->w_out + (size_t)l * 1024 * 1024, 1024, 1024, (bf16_t*)(p->ws + OFF_WOUT), 0, t - 1024, lds);
    else if (t < 1440) convert_one(p->w_up + (size_t)l * 1024 * DFF2, 1024, DFF2, (bf16_t*)(p->ws + OFF_WUP), 2, t - 1088, lds);
    else convert_one(p->w_down + (size_t)l * DFF * 1024, DFF, 1024, (bf16_t*)(p->ws + OFF_WDN), 0, t - 1440, lds);
}
DEV void phase_convert(KP p, int l, float* lds) {
    p = fresh(p);
    for (int t = blockIdx.x; t < 832; t += gridDim.x) convert_tile(p, l, t, lds);
}
DEV void convert_queue(KP p, float* lds, int cidx, int first, int last, int maxn) {
    p = fresh(p);
    unsigned* ctr = (unsigned*)(p->ws + OFF_BAR) + 3776 + 64 * cidx;
    volatile LAS3 unsigned* bc = (volatile LAS3 unsigned*)((LAS3 unsigned char*)lds + LDS_BYTES - 8);
    for (int k = 0; k < maxn; ++k) {
        __syncthreads();
        if (otid() == 0) *bc = xb_add(ctr, 1u);
        __syncthreads();
        const int t = first + (int)*bc;
        if (t >= last) break;
        convert_tile(p, 1, t, lds);
    }
    __syncthreads();
}

DEV void phase_norm(KP p, int mode, int nwsel, int lmod, int gate_idx, int sc_idx, int sh_idx) {
    p = fresh(p);
    const int tid = otid(), wid = tid >> 6, lane = tid & 63;
    const float* nw = nwsel < 2 ? p->norm1 + nwsel * 1024 : (nwsel < 4 ? p->norm2 + (nwsel - 2) * 1024 : p->final_norm);
    float* xbuf = p->out + OUT_Y;
    const bf16_t* P = (const bf16_t*)(p->ws + OFF_P);
    const bf16_t* P1 = (const bf16_t*)(p->ws + OFF_P1);
    const float* mods = (const float*)(p->ws + OFF_MODS);
    bf16_t* h = (bf16_t*)(p->ws + OFF_H);
    const float* xp = p->x_prompt; const float* xs = p->x_sample;
    const int stride = gridDim.x * 8;
    for (int row0 = blockIdx.x * 8 + wid; row0 < NTOK; row0 += 2 * stride) {
        f32x4 x[2][4], sc[2][4], sh[2][4], w[4];
        float ss[2] = {0.f, 0.f};
#pragma unroll
        for (int i = 0; i < 4; ++i) w[i] = *(const f32x4*)(nw + lane * 4 + 256 * i);
#pragma unroll
        for (int r = 0; r < 2; ++r) {
            const int row = row0 + r * stride;
            if (row < NTOK) {
                const int v = row_modvec(row);
#pragma unroll
                for (int i = 0; i < 4; ++i) {
                    const int c = lane * 4 + 256 * i;
                    if (mode == 0) {
                        const float* src = row < NCTX ? xp + (size_t)row * 1024 : xs + (size_t)(row - NCTX) * 1024;
                        x[r][i] = *(const f32x4*)(src + c);
                    } else {
                        x[r][i] = *(const f32x4*)(xbuf + (size_t)row * 1024 + c);
                        const u16x4 q0 = *(const u16x4*)(P + (size_t)row * 1024 + c), q1 = *(const u16x4*)(P1 + (size_t)row * 1024 + c);
                        const f32x4 g = *(const f32x4*)(mods + ((size_t)(gate_idx >> 3) * 5 + v) * 6144 + (gate_idx & 7) * 1024 + c);
                        f32x4 pv; pv[0] = bf2f(q0[0]) + bf2f(q1[0]); pv[1] = bf2f(q0[1]) + bf2f(q1[1]); pv[2] = bf2f(q0[2]) + bf2f(q1[2]); pv[3] = bf2f(q0[3]) + bf2f(q1[3]);
                        x[r][i] = x[r][i] + g * pv;
                    }
                    if (mode != 2) {
                        sc[r][i] = *(const f32x4*)(mods + ((size_t)lmod * 5 + v) * 6144 + sc_idx * 1024 + c);
                        sh[r][i] = *(const f32x4*)(mods + ((size_t)lmod * 5 + v) * 6144 + sh_idx * 1024 + c);
                    }
                    ss[r] += x[r][i][0] * x[r][i][0] + x[r][i][1] * x[r][i][1] + x[r][i][2] * x[r][i][2] + x[r][i][3] * x[r][i][3];
                }
            }
        }
        ss[0] = wave_sum(ss[0], lane); ss[1] = wave_sum(ss[1], lane);
#pragma unroll
        for (int r = 0; r < 2; ++r) {
            const int row = row0 + r * stride;
            if (row < NTOK) {
                const float rstd = rsqrtf(ss[r] * (1.f / 1024.f) + EPS);
#pragma unroll
                for (int i = 0; i < 4; ++i) {
                    const int c = lane * 4 + 256 * i;
                    if (mode == 2) {
                        *(f32x4*)(xbuf + (size_t)row * 1024 + c) = x[r][i] * rstd * w[i];
                    } else {
                        *(f32x4*)(xbuf + (size_t)row * 1024 + c) = x[r][i];
                        store_bf4(h + (size_t)row * 1024 + c, x[r][i] * rstd * w[i] * (sc[r][i] + 1.f) + sh[r][i]);
                    }
                }
            }
        }
    }
}

struct Seg { const bf16_t* A; const bf16_t* Bt; int lda, ldb, K; };

DEV void gemm_seg_simple(f32x4 (&acc)[2][2][4][2], const Seg& s, int pm, int pn, bf16_t* lds) {
    const int tid = otid(), wid = tid >> 6, lane = tid & 63, wr = wid >> 2, wc = wid & 3, fr = lane & 15, fq = lane >> 4;
    bf16_t* sA = lds;
    bf16_t* sB = lds + 256 * 40;
    const int lr = tid >> 2, lc = (tid & 3) * 8;
    for (int k0 = 0; k0 < s.K; k0 += 32) {
#pragma unroll
        for (int i = 0; i < 2; ++i) {
            const int r = lr + 128 * i;
            *(bf16x8*)(sA + r * 40 + lc) = *(const bf16x8*)(s.A + (size_t)(pm * 256 + r) * s.lda + k0 + lc);
            *(bf16x8*)(sB + r * 40 + lc) = *(const bf16x8*)(s.Bt + (size_t)(pn * 256 + r) * s.ldb + k0 + lc);
        }
        __syncthreads();
        bf16x8 bfr[2][2];
#pragma unroll
        for (int bj = 0; bj < 2; ++bj)
#pragma unroll
            for (int n = 0; n < 2; ++n) bfr[bj][n] = *(const bf16x8*)(sB + (128 * bj + 32 * wc + 16 * n + fr) * 40 + fq * 8);
#pragma unroll
        for (int ai = 0; ai < 2; ++ai)
#pragma unroll
            for (int m = 0; m < 4; ++m) {
                const bf16x8 af = *(const bf16x8*)(sA + (128 * ai + 64 * wr + 16 * m + fr) * 40 + fq * 8);
#pragma unroll
                for (int bj = 0; bj < 2; ++bj)
#pragma unroll
                    for (int n = 0; n < 2; ++n) acc[ai][bj][m][n] = __builtin_amdgcn_mfma_f32_16x16x32_bf16(bfr[bj][n], af, acc[ai][bj][m][n], 0, 0, 0);
            }
        __syncthreads();
    }
}

template <class F>
DEV void for_acc(f32x4 (&acc)[2][2][4][2], int pm, int pn, F f) {
    const int tid = otid(), wid = tid >> 6, lane = tid & 63, wr = wid >> 2, wc = wid & 3, fr = lane & 15, fq = lane >> 4;
#pragma unroll
    for (int a = 0; a < 2; ++a)
#pragma unroll
        for (int b = 0; b < 2; ++b)
#pragma unroll
            for (int m = 0; m < 4; ++m)
#pragma unroll
                for (int n = 0; n < 2; ++n) f(pm * 256 + 128 * a + 64 * wr + 16 * m + fr, pn * 256 + 64 * wc + 32 * b + 8 * fq + 4 * n, acc[a][b][m][n]);
}
template <class F>
DEV void for_acc2(f32x4 (&acc)[2][2][4][2], int pm, int pn, F f) {
    const int tid = otid(), wid = tid >> 6, lane = tid & 63, wr = wid >> 2, wc = wid & 3, fr = lane & 15, fq = lane >> 4;
#pragma unroll
    for (int a = 0; a < 2; ++a)
#pragma unroll
        for (int b = 0; b < 2; ++b)
#pragma unroll
            for (int m = 0; m < 4; ++m) f(pm * 256 + 128 * a + 64 * wr + 16 * m + fr, pn * 256 + 64 * wc + 32 * b + 8 * fq, acc[a][b][m][0], acc[a][b][m][1]);
}
DEV void zero_acc(f32x4 (&acc)[2][2][4][2]) {
#pragma unroll
    for (int a = 0; a < 2; ++a)
#pragma unroll
        for (int b = 0; b < 2; ++b)
#pragma unroll
            for (int m = 0; m < 4; ++m)
#pragma unroll
                for (int n = 0; n < 2; ++n) acc[a][b][m][n] = (f32x4){0.f, 0.f, 0.f, 0.f};
}

template <class Epi>
DEV void gemm_phase_simple(int nM, int nN, const Seg s0, const Seg s1, bool two, const Epi& E, bf16_t* lds) {
    for (int u = blockIdx.x; u < nM * nN; u += gridDim.x) {
        const int pm = u % nM, pn = u / nM;
        f32x4 acc[2][2][4][2];
        zero_acc(acc);
        gemm_seg_simple(acc, s0, pm, pn, lds);
        if (two) {
            E.mid(acc, pm, pn);
            gemm_seg_simple(acc, s1, pm, pn, lds);
        }
        E.fin(acc, pm, pn);
    }
}

#define LAS __attribute__((address_space(3)))
constexpr int HTB = 128 * 64 * 2;
DEV int lds_byte(int r, int c) { const int st = (r >> 4) * 2 + (c >> 5), rr = r & 15, cc = c & 31, ob = rr * 64 + cc * 2; return st * 1024 + (ob ^ (((ob >> 9) & 1) << 5)); }
DEV void stage_rc(int b, int& R, int& C) { const int st = b / 1024, sb = b % 1024, swz = sb ^ (((sb >> 9) & 1) << 5); R = (st >> 1) * 16 + swz / 64; C = (st & 1) * 32 + (swz % 64) / 2; }
struct Step { const char* A; const char* B; unsigned lda, ldb; int nt, pm, pn, kind, half; };
struct Prog {
    const bf16_t *A0, *B0, *A1, *B1; int lda0, ldb0, K0, lda1, ldb1, K1a, K1b, mode, ks, bsame, pnmap;
    int nM, nN, nwg, G, c;
    int j, stp;
    DEV void tile_of(int t, int& pm, int& pn) const {
        int wgid = t; { const int q = nwg / 8, r = nwg % 8, xcd = wgid % 8, off = wgid / 8; wgid = (xcd < r ? xcd * (q + 1) : r * (q + 1) + (xcd - r) * q) + off; }
        const int nig = 8 * nN, gid = wgid / nig, fm = gid * 8, gsz = (nM - fm) < 8 ? (nM - fm) : 8;
        pm = fm + ((wgid % nig) % gsz); pn = (wgid % nig) / gsz;
        if (pnmap == 1) pn = pn < 16 ? pn : pn + 4;
        else if (pnmap == 2) pn = pn < 4 ? 16 + pn : 32 + pn;
    }
    DEV bool next(Step& st) {
        const long L = (long)j * G + c;
        if (L >= (long)nwg * ks) return false;
        const int u = (int)L, tile = u / ks, half = u % ks;
        tile_of(tile, st.pm, st.pn); st.half = half;
        if (mode == 0) {
            st.lda = lda0 * 2; st.ldb = ldb0 * 2; st.nt = K0 / 64; st.kind = 0;
            const bf16_t* a = (half && A1) ? A1 : A0 + (size_t)half * K0 * (A1 ? 0 : 1);
            const bf16_t* bq = B0 + (size_t)half * K0 * (bsame ? 0 : 1);
            st.A = (const char*)a + (size_t)st.pm * 256 * st.lda; st.B = (const char*)bq + (size_t)st.pn * 256 * st.ldb;
            ++j;
        } else {
            if (half == 0 && stp == 0) {
                st.lda = lda0 * 2; st.ldb = ldb0 * 2; st.nt = K0 / 64; st.kind = 1;
                st.A = (const char*)A0 + (size_t)st.pm * 256 * st.lda; st.B = (const char*)B0 + (size_t)st.pn * 256 * st.ldb;
                stp = 1;
            } else {
                st.lda = lda1 * 2; st.ldb = ldb1 * 2; st.kind = 0;
                const int koff = half ? K1a : 0; st.nt = (half ? K1b : K1a) / 64;
                st.A = (const char*)(A1 + koff) + (size_t)st.pm * 256 * st.lda; st.B = (const char*)(B1 + koff) + (size_t)st.pn * 256 * st.ldb;
                stp = 0; ++j;
            }
        }
        return true;
    }
};
template <class Epi>
DEV void gemm_phase8(LAS unsigned char* lds, Prog& S, const Epi& E) {
    const int tid = otid(), wid = __builtin_amdgcn_readfirstlane(tid >> 6), lane = tid & 63, wr = wid >> 2, wc = wid & 3, fr = lane & 15, fq = lane >> 4;
    unsigned sR[2], sC2[2];
#pragma unroll
    for (int i = 0; i < 2; ++i) { int R, C; stage_rc(tid * 16 + i * 8192, R, C); sR[i] = (unsigned)R; sC2[i] = (unsigned)C * 2u; }
    const size_t kstep = 128;
    const unsigned ldsw = (unsigned)wid * 1024u;
    const int aoff = lds_byte(wr * 64 + fr, fq * 8), boff = lds_byte(wc * 32 + fr, fq * 8);
#define G8_SA(b, h) (((b) * 2 + (h)) * HTB)
#define G8_SB(b, h) ((4 + (b) * 2 + (h)) * HTB)
#define G8_STAGE(bufoff, gbase, ld) do { _Pragma("unroll") for (int _i = 0; _i < 2; ++_i) \
        __builtin_amdgcn_global_load_lds((const unsigned*)((const char*)(gbase) + (size_t)(sR[_i] * (ld) + sC2[_i])), (LAS unsigned*)(lds + (bufoff) + ldsw + _i * 8192), 16, 0, 0); } while (0)
#define G8_LDA(dst, b, h) do { _Pragma("unroll") for (int m = 0; m < 4; ++m) _Pragma("unroll") for (int k = 0; k < 2; ++k) dst[m][k] = *(const LAS bf16x8*)(lds + G8_SA(b, h) + aoff + m * 2048 + k * 1024); } while (0)
#define G8_LDB(dst, b, h) do { _Pragma("unroll") for (int n = 0; n < 2; ++n) _Pragma("unroll") for (int k = 0; k < 2; ++k) dst[n][k] = *(const LAS bf16x8*)(lds + G8_SB(b, h) + boff + n * 2048 + k * 1024); } while (0)
#define G8_MMA(ai, bj, At, Bt) do { __builtin_amdgcn_s_setprio(1); _Pragma("unroll") for (int m = 0; m < 4; ++m) _Pragma("unroll") for (int n = 0; n < 2; ++n) _Pragma("unroll") for (int k = 0; k < 2; ++k) \
        acc[ai][bj][m][n] = __builtin_amdgcn_mfma_f32_16x16x32_bf16(Bt[n][k], At[m][k], acc[ai][bj][m][n], 0, 0, 0); __builtin_amdgcn_s_setprio(0); } while (0)
#define G8_WAIT_V(n) asm volatile("s_waitcnt vmcnt(" #n ")" ::: "memory")
#define G8_WAIT_L(n) asm volatile("s_waitcnt lgkmcnt(" #n ")" ::: "memory")
#define G8_BAR __builtin_amdgcn_s_barrier()
#define G8_SCHED __builtin_amdgcn_sched_barrier(0)
    Step cur, nxt;
    if (!S.next(cur)) return;
    f32x4 acc[2][2][4][2];
    zero_acc(acc);
    bf16x8 At[4][2], B0[2][2], B1[2][2];
    {
        const char* cA = cur.A; const char* cB = cur.B; const unsigned la = cur.lda, lb = cur.ldb; const size_t hA = (size_t)128 * la, hB = (size_t)128 * lb;
        G8_STAGE(G8_SB(0, 0), cB, lb); G8_STAGE(G8_SA(0, 0), cA, la); G8_STAGE(G8_SB(0, 1), cB + hB, lb); G8_STAGE(G8_SA(0, 1), cA + hA, la);
        if (wr == 1) G8_BAR;
        G8_WAIT_V(4); G8_BAR;
        G8_STAGE(G8_SB(1, 0), cB + kstep, lb); G8_STAGE(G8_SA(1, 0), cA + kstep, la); G8_STAGE(G8_SB(1, 1), cB + hB + kstep, lb);
        G8_WAIT_V(6); G8_BAR;
    }
    for (;;) {
        const bool has_next = S.next(nxt);
        if (!has_next) nxt = cur;
        const char* cA = cur.A; const char* cB = cur.B; const unsigned la = cur.lda, lb = cur.ldb; const size_t hA = (size_t)128 * la, hB = (size_t)128 * lb;
        const int nt = cur.nt;
        for (int t = 0; t < nt; t += 2) {
            const bool last = (t == nt - 2);
            const char* a1 = cA + (size_t)(t + 1) * kstep;
            const char* a2 = last ? nxt.A : cA + (size_t)(t + 2) * kstep; const char* b2 = last ? nxt.B : cB + (size_t)(t + 2) * kstep;
            const unsigned la2 = last ? nxt.lda : la, lb2 = last ? nxt.ldb : lb; const size_t hA2 = (size_t)128 * la2, hB2 = (size_t)128 * lb2;
            const char* a3 = a2 + kstep; const char* b3 = b2 + kstep;
            G8_LDB(B0, 0, 0); G8_SCHED; G8_LDA(At, 0, 0); G8_STAGE(G8_SA(1, 1), a1 + hA, la);
            G8_WAIT_L(8); G8_BAR; G8_WAIT_L(0); G8_MMA(0, 0, At, B0); G8_BAR; G8_SCHED;
            G8_LDB(B1, 0, 1); G8_STAGE(G8_SB(0, 0), b2, lb2);
            G8_BAR; G8_WAIT_L(0); G8_MMA(0, 1, At, B1); G8_BAR;
            G8_LDA(At, 0, 1); G8_STAGE(G8_SA(0, 0), a2, la2);
            G8_BAR; G8_WAIT_L(0); G8_MMA(1, 0, At, B0); G8_BAR; G8_SCHED;
            G8_STAGE(G8_SB(0, 1), b2 + hB2, lb2);
            G8_WAIT_V(6); G8_BAR; G8_MMA(1, 1, At, B1); G8_BAR;
            G8_LDB(B0, 1, 0); G8_SCHED; G8_LDA(At, 1, 0); G8_STAGE(G8_SA(0, 1), a2 + hA2, la2);
            G8_WAIT_L(8); G8_BAR; G8_WAIT_L(0); G8_MMA(0, 0, At, B0); G8_BAR; G8_SCHED;
            G8_LDB(B1, 1, 1); G8_STAGE(G8_SB(1, 0), b3, lb2);
            G8_BAR; G8_WAIT_L(0); G8_MMA(0, 1, At, B1); G8_BAR;
            G8_LDA(At, 1, 1); G8_STAGE(G8_SA(1, 0), a3, la2);
            G8_BAR; G8_WAIT_L(0); G8_MMA(1, 0, At, B0); G8_BAR; G8_SCHED;
            G8_STAGE(G8_SB(1, 1), b3 + hB2, lb2);
            G8_WAIT_V(6); G8_BAR; G8_MMA(1, 1, At, B1); G8_BAR;
        }
        if (cur.kind == 1) E.mid(acc, cur.pm, cur.pn);
        else { E.fin(acc, cur.pm, cur.pn, cur.half); }
        if (!has_next) break;
        if (cur.kind == 0) zero_acc(acc);
        cur = nxt;
    }
    G8_WAIT_V(0);
    if (wr == 0) G8_BAR;
    G8_BAR;
#undef G8_SA
#undef G8_SB
#undef G8_STAGE
#undef G8_LDA
#undef G8_LDB
#undef G8_MMA
#undef G8_WAIT_V
#undef G8_WAIT_L
#undef G8_BAR
#undef G8_SCHED
}
template <class Epi>
DEV void gemm_run(Prog S, int nM, int nN, const Epi& E, bf16_t* ldsg) {
    S.nM = nM; S.nN = nN; S.nwg = nM * nN; S.G = gridDim.x; S.c = blockIdx.x; S.j = 0; S.stp = 0;
    gemm_phase8((LAS unsigned char*)ldsg, S, E);
}
template <class Epi>
DEV void gemm_one(Prog S, int nM, int nN, int unit, const Epi& E, bf16_t* ldsg) {
    S.nM = nM; S.nN = nN; S.nwg = nM * nN; S.G = 1 << 24; S.c = unit; S.j = 0; S.stp = 0;
    gemm_phase8((LAS unsigned char*)ldsg, S, E);
}
DEV Prog prog_plain(const bf16_t* A, const bf16_t* Bt, int lda, int ldb, int K) {
    Prog S; S.A0 = A; S.B0 = Bt; S.A1 = nullptr; S.B1 = nullptr; S.lda0 = lda; S.ldb0 = ldb; S.K0 = K; S.lda1 = 0; S.ldb1 = 0; S.K1a = 0; S.K1b = 0; S.mode = 0; S.ks = 1; S.bsame = 0; S.pnmap = 0; return S;
}


DEV u32x4 pack8(f32x4 v0, f32x4 v1) { u32x4 o; o[0] = pk2(v0[0], v0[1]); o[1] = pk2(v0[2], v0[3]); o[2] = pk2(v1[0], v1[1]); o[3] = pk2(v1[2], v1[3]); return o; }
DEV void stage_rows(bf16_t* dst, int ld, int rowbase, int colbase, u32x4 v0, u32x4 v1, int w, int fr, int fq, int lane) {
    extern __shared__ __attribute__((aligned(16))) unsigned char smem_x[];
    unsigned char* st = smem_x + 131072 + w * 2304;
    *(u32x4*)(st + fr * 144 + 16 * fq) = v0;
    *(u32x4*)(st + fr * 144 + 64 + 16 * fq) = v1;
    __builtin_amdgcn_wave_barrier();
    const int r = lane >> 3, pc = lane & 7;
    const u32x4 o0 = *(const u32x4*)(st + r * 144 + 16 * pc), o1 = *(const u32x4*)(st + (8 + r) * 144 + 16 * pc);
    *(u32x4*)(dst + (size_t)(rowbase + r) * ld + colbase + 8 * pc) = o0;
    *(u32x4*)(dst + (size_t)(rowbase + 8 + r) * ld + colbase + 8 * pc) = o1;
    __builtin_amdgcn_wave_barrier();
}
template <class G>
DEV void store_tile_rows(f32x4 (&acc)[2][2][4][2], int pm, bf16_t* dst, int ld, int coloff, G g) {
    const int tid = otid(), wid = tid >> 6, lane = tid & 63, wr = wid >> 2, wc = wid & 3, fr = lane & 15, fq = lane >> 4;
#pragma unroll
    for (int a = 0; a < 2; ++a)
#pragma unroll
        for (int m = 0; m < 4; ++m)
            stage_rows(dst, ld, pm * 256 + 128 * a + 64 * wr + 16 * m, coloff + 64 * wc, pack8(g(acc[a][0][m][0]), g(acc[a][0][m][1])), pack8(g(acc[a][1][m][0]), g(acc[a][1][m][1])), wid, fr, fq, lane);
}
DEV float logf_gate(float z, float lb) {
    const float e = __expf(-fabsf(z));
    const float r = __builtin_amdgcn_rcpf(1.f + e);
    const float sig = z >= 0.f ? r : e * r;
    return __builtin_amdgcn_logf(lb + (1.f - lb) * sig) * 0.6931471805599453f;
}

struct EpiInProj {
    unsigned char* ws; int l;
    DEV void mid(f32x4 (&)[2][2][4][2], int, int) const {}
    DEV void fin(f32x4 (&acc)[2][2][4][2], int pm, int pn, int half) const {
        const int col0 = pn * 256;
        unsigned char* w = ws; const int ll = l;
        if (col0 < 1024) { store_tile_rows(acc, pm, (bf16_t*)(w + OFF_QA), 1024, pn * 256 - 0, [](f32x4 v) { return v; }); }
        else if (col0 < 3072) {
            const int dir = col0 >= 2048;
            const float* lbp = (const float*)(w + OFF_LB) + (ll * 2 + dir) * 1024;
            float* dst = (float*)(w + (dir ? OFF_LFB : OFF_LFF));
            {
                const int tid = otid(), wid = tid >> 6, lane = tid & 63, wr = wid >> 2, wc = wid & 3, fr = lane & 15, fq = lane >> 4;
                const int cb = pn * 256 - 1024 - dir * 1024 + 64 * wc + 4 * fq;
                f32x4 lb4[2][2];
#pragma unroll
                for (int b = 0; b < 2; ++b)
#pragma unroll
                    for (int n = 0; n < 2; ++n) lb4[b][n] = *(const f32x4*)(lbp + cb + 32 * b + 16 * n);
#pragma unroll
                for (int a = 0; a < 2; ++a)
#pragma unroll
                    for (int m = 0; m < 4; ++m)
#pragma unroll
                        for (int b = 0; b < 2; ++b)
#pragma unroll
                            for (int n = 0; n < 2; ++n) {
                                const int row = pm * 256 + 128 * a + 64 * wr + 16 * m + fr;
                                f32x4 o;
#pragma unroll
                                for (int j = 0; j < 4; ++j) o[j] = logf_gate(acc[a][b][m][n][j], lb4[b][n][j]);
                                *(f32x4*)(dst + (size_t)row * 1024 + cb + 32 * b + 16 * n) = o;
                            }
            }
        }
        else if (col0 < 4096) { store_tile_rows(acc, pm, (bf16_t*)(w + OFF_IA), 1024, pn * 256 - 3072, [](f32x4 v) { return v; }); }
        else if (col0 < 5120) { store_tile_rows(acc, pm, (bf16_t*)(w + OFF_GA), 1024, pn * 256 - 4096, [](f32x4 v) { return v; }); }
        else if (col0 < 7168) {
            const int isk = col0 >= 6144;
            const float scale = isk ? 0.0625f : 1.f;
            bf16_t* dbase = (bf16_t*)(w + (isk ? OFF_KB : OFF_QB));
            const float* rope = (const float*)(w + OFF_ROPE);
            {
                const int tid = otid(), wid = tid >> 6, lane = tid & 63, wr = wid >> 2, wc = wid & 3, fr = lane & 15, fq = lane >> 4;
#pragma unroll
                for (int a = 0; a < 2; ++a) {
                    f32x4 cs0[2][4], cs1[2][4];
#pragma unroll
                    for (int b = 0; b < 2; ++b)
#pragma unroll
                        for (int m = 0; m < 4; ++m) {
                            const int row = pm * 256 + 128 * a + 64 * wr + 16 * m + fr;
                            const int g = 8 * (wc & 1) + 4 * b + fq;
                            const int t = (row - NCTX) & 1023, pos = (wc >> 1) ? (t & 63) : (t >> 6);
                            cs0[b][m] = *(const f32x4*)(rope + (pos * 64 + 4 * g) * 2); cs1[b][m] = *(const f32x4*)(rope + (pos * 64 + 4 * g) * 2 + 4);
                        }
#pragma unroll
                    for (int b = 0; b < 2; ++b)
#pragma unroll
                        for (int m = 0; m < 4; ++m) {
                            const int row = pm * 256 + 128 * a + 64 * wr + 16 * m + fr;
                            const int g = 8 * (wc & 1) + 4 * b + fq, hh = pn & 3;
                            const f32x4 x1 = acc[a][b][m][0] * scale, x2 = acc[a][b][m][1] * scale;
                            f32x4 o1 = x1, o2 = x2;
                            if (row >= NCTX) {
                                const f32x4 c0 = cs0[b][m], c1 = cs1[b][m];
                                o1[0] = x1[0] * c0[0] - x2[0] * c0[1]; o2[0] = x1[0] * c0[1] + x2[0] * c0[0];
                                o1[1] = x1[1] * c0[2] - x2[1] * c0[3]; o2[1] = x1[1] * c0[3] + x2[1] * c0[2];
                                o1[2] = x1[2] * c1[0] - x2[2] * c1[1]; o2[2] = x1[2] * c1[1] + x2[2] * c1[0];
                                o1[3] = x1[3] * c1[2] - x2[3] * c1[3]; o2[3] = x1[3] * c1[3] + x2[3] * c1[2];
                            }
                            bf16_t* dstp = dbase + (size_t)row * 1024 + hh * 256 + (wc >> 1) * 128 + 4 * g;
                            store_bf4(dstp, o1);
                            store_bf4(dstp + 64, o2);
                        }
                }
            }
        }
        else if (col0 < 9216) { store_tile_rows(acc, pm, (bf16_t*)(w + OFF_VB), 2048, pn * 256 - 7168, [](f32x4 v) { return v; }); }
        else if (col0 < 11264) { store_tile_rows(acc, pm, (bf16_t*)(w + OFF_GB), 2048, pn * 256 - 9216, [](f32x4 v) { return v; }); }
        else {
            const int isb = col0 >= 12288;
            bf16_t* dbase = (bf16_t*)(w + (isb ? OFF_SGB : OFF_SGA));
            store_tile_rows(acc, pm, dbase, 1024, pn * 256 - 11264 - isb * 1024, [](f32x4 v) { f32x4 o; o[0] = sigmoidf_(v[0]); o[1] = sigmoidf_(v[1]); o[2] = sigmoidf_(v[2]); o[3] = sigmoidf_(v[3]); return o; });
        }
    }
};
struct EpiMerged {
    unsigned char* ws;
    DEV void mid(f32x4 (&acc)[2][2][4][2], int pm, int pn) const {
        const bf16_t* sga = (const bf16_t*)(ws + OFF_SGA); const bf16_t* sgb = (const bf16_t*)(ws + OFF_SGB);
        for_acc(acc, pm, pn, [&](int row, int col, f32x4& v) {
            const u16x4 a = *(const u16x4*)(sga + (size_t)row * 1024 + col);
            const u16x4 b = *(const u16x4*)(sgb + (size_t)row * 1024 + col);
#pragma unroll
            for (int j = 0; j < 4; ++j) v[j] *= bf2f(a[j]) * __builtin_amdgcn_rcpf(fmaxf(bf2f(b[j]), 1e-30f));
        });
    }
    DEV void fin(f32x4 (&acc)[2][2][4][2], int pm, int pn, int half) const {
        const bf16_t* sgb = (const bf16_t*)(ws + OFF_SGB); bf16_t* mg = (bf16_t*)(ws + OFF_MERGED) + (size_t)half * NTOK * 1024;
        const int tid = otid(), wid = tid >> 6, lane = tid & 63, wr = wid >> 2, wc = wid & 3, fr = lane & 15, fq = lane >> 4;
        const int cb = pn * 256 + 64 * wc + 8 * fq;
#pragma unroll
        for (int a = 0; a < 2; ++a) {
            u16x8 gb[2][4];
#pragma unroll
            for (int b = 0; b < 2; ++b)
#pragma unroll
                for (int m = 0; m < 4; ++m) gb[b][m] = *(const u16x8*)(sgb + (size_t)(pm * 256 + 128 * a + 64 * wr + 16 * m + fr) * 1024 + cb + 32 * b);
#pragma unroll
            for (int b = 0; b < 2; ++b)
#pragma unroll
                for (int m = 0; m < 4; ++m) {
                    const size_t off = (size_t)(pm * 256 + 128 * a + 64 * wr + 16 * m + fr) * 1024 + cb + 32 * b;
                    u32x4 o;
#pragma unroll
                    for (int n = 0; n < 2; ++n) {
                        const f32x4 v = acc[a][b][m][n];
                        o[2 * n] = pk2(v[0] * fmaxf(bf2f(gb[b][m][4 * n]), 1e-30f), v[1] * fmaxf(bf2f(gb[b][m][4 * n + 1]), 1e-30f));
                        o[2 * n + 1] = pk2(v[2] * fmaxf(bf2f(gb[b][m][4 * n + 2]), 1e-30f), v[3] * fmaxf(bf2f(gb[b][m][4 * n + 3]), 1e-30f));
                    }
                    *(u32x4*)(mg + off) = o;
                }
        }
    }
};
struct EpiF32 {
    float* C; float* C1; int ldc;
    DEV void mid(f32x4 (&)[2][2][4][2], int, int) const {}
    DEV void fin(f32x4 (&acc)[2][2][4][2], int pm, int pn, int half) const {
        float* c = half ? C1 : C; const int ld = ldc;
        for_acc(acc, pm, pn, [&](int row, int col, f32x4& v) { *(f32x4*)(c + (size_t)row * ld + col) = v; });
    }
};
struct EpiBf {
    bf16_t* C; bf16_t* C1; int ldc;
    DEV void mid(f32x4 (&)[2][2][4][2], int, int) const {}
    DEV void fin(f32x4 (&acc)[2][2][4][2], int pm, int pn, int half) const {
        bf16_t* c = half ? C1 : C; const int ld = ldc;
        store_tile_rows(acc, pm, c, ld, pn * 256, [](f32x4 v) { return v; });
    }
};

#define ROR1(x)  __int_as_float(__builtin_amdgcn_update_dpp(0, __float_as_int(x), 0x121, 0xf, 0xf, false))
#define ROR15(x) __int_as_float(__builtin_amdgcn_update_dpp(0, __float_as_int(x), 0x12F, 0xf, 0xf, false))
struct EpiUpConv {
    unsigned char* ws; const float* wc_; const float* bc_;
    DEV void mid(f32x4 (&)[2][2][4][2], int, int) const {}
    DEV void fin(f32x4 (&acc)[2][2][4][2], int pm, int pn, int) const {
        const int tid = otid(), wid = tid >> 6, lane = tid & 63, wr = wid >> 2, wc = wid & 3, fr = lane & 15, fq = lane >> 4;
        bf16_t* act = (bf16_t*)(ws + OFF_ACT); bf16_t* ub = (bf16_t*)(ws + OFF_UB);
        const int ip = ((lane & 48) | ((fr + 15) & 15)) << 2, in = ((lane & 48) | ((fr + 1) & 15)) << 2;
#pragma unroll
        for (int b = 0; b < 2; ++b) {
            const int ch = pn * 128 + 4 * (8 * wc + 4 * b + fq);
            const f32x4 wa0 = *(const f32x4*)(wc_ + ch), wa1 = *(const f32x4*)(wc_ + DFF2 + ch), wa2 = *(const f32x4*)(wc_ + 2 * DFF2 + ch), ba = *(const f32x4*)(bc_ + ch);
            const f32x4 wg0 = *(const f32x4*)(wc_ + DFF + ch), wg1 = *(const f32x4*)(wc_ + DFF2 + DFF + ch), wg2 = *(const f32x4*)(wc_ + 2 * DFF2 + DFF + ch), bg = *(const f32x4*)(bc_ + DFF + ch);
#pragma unroll
            for (int a = 0; a < 2; ++a)
#pragma unroll
                for (int m = 0; m < 4; ++m) {
                    const int row = pm * 256 + 128 * a + 64 * wr + 16 * m + fr;
                    f32x4 pa, na, pg, ng;
#pragma unroll
                    for (int j = 0; j < 4; ++j) {
                        const float ca = acc[a][b][m][0][j], cg = acc[a][b][m][1][j];
                        const float sa_p = (m > 0 && fr == 15) ? acc[a][b][m > 0 ? m - 1 : 0][0][j] : ((m == 0 && fr == 15) ? 0.f : ca);
                        const float sg_p = (m > 0 && fr == 15) ? acc[a][b][m > 0 ? m - 1 : 0][1][j] : ((m == 0 && fr == 15) ? 0.f : cg);
                        const float sa_n = (m < 3 && fr == 0) ? acc[a][b][m < 3 ? m + 1 : 3][0][j] : ((m == 3 && fr == 0) ? 0.f : ca);
                        const float sg_n = (m < 3 && fr == 0) ? acc[a][b][m < 3 ? m + 1 : 3][1][j] : ((m == 3 && fr == 0) ? 0.f : cg);
                        pa[j] = ROR1(sa_p); pg[j] = ROR1(sg_p);
                        na[j] = ROR15(sa_n); ng[j] = ROR15(sg_n);
                    }
                    const f32x4 va = ba + wa0 * pa + wa1 * acc[a][b][m][0] + wa2 * na;
                    const f32x4 vg = bg + wg0 * pg + wg1 * acc[a][b][m][1] + wg2 * ng;
                    f32x4 o;
#pragma unroll
                    for (int j = 0; j < 4; ++j) o[j] = siluf_(vg[j]) * va[j];
                    store_bf4(act + (size_t)row * DFF + ch, o);
                    const int pos = row & 63;
                    if (pos < 2 || pos >= 62) {
                        bf16_t* up = ub + (size_t)((row >> 6) * 4 + (pos < 2 ? pos : pos - 60)) * DFF2;
                        store_bf4(up + ch, acc[a][b][m][0]);
                        store_bf4(up + DFF + ch, acc[a][b][m][1]);
                    }
                }
        }
    }
};
DEV void conv_fixup(unsigned char* ws, const float* wc_, const float* bc_, int pm, int c0) {
    const int tid = otid();
    bf16_t* act = (bf16_t*)(ws + OFF_ACT); const bf16_t* ub = (const bf16_t*)(ws + OFF_UB);
    for (int idx = tid; idx < 8 * 352; idx += NTHR) {
        const int ri = idx / 352, cq = idx % 352, ch = c0 + 4 * cq;
        const int R = pm * 256 + (ri >> 1) * 64 + ((ri & 1) ? 63 : 0);
        const int t = R < NCTX ? (R & 255) : ((R - NCTX) & 1023), T = R < NCTX ? 256 : 1024;
        const int blk = R >> 6;
        const bf16_t *rp, *rc, *rn;
        if (ri & 1) { rp = ub + (size_t)(blk * 4 + 2) * DFF2; rc = ub + (size_t)(blk * 4 + 3) * DFF2; rn = ub + (size_t)((blk + 1) * 4 + 0) * DFF2; }
        else { rp = ub + (size_t)((blk - 1) * 4 + 3) * DFF2; rc = ub + (size_t)(blk * 4 + 0) * DFF2; rn = ub + (size_t)(blk * 4 + 1) * DFF2; }
        const bool hp = t > 0, hn = t < T - 1;
        f32x4 va = *(const f32x4*)(bc_ + ch), vg = *(const f32x4*)(bc_ + DFF + ch);
        {
            const u16x4 xa = *(const u16x4*)(rc + ch), xg = *(const u16x4*)(rc + DFF + ch);
            const f32x4 wa = *(const f32x4*)(wc_ + DFF2 + ch), wg = *(const f32x4*)(wc_ + DFF2 + DFF + ch);
#pragma unroll
            for (int j = 0; j < 4; ++j) { va[j] += wa[j] * bf2f(xa[j]); vg[j] += wg[j] * bf2f(xg[j]); }
        }
        if (hp) {
            const u16x4 xa = *(const u16x4*)(rp + ch), xg = *(const u16x4*)(rp + DFF + ch);
            const f32x4 wa = *(const f32x4*)(wc_ + ch), wg = *(const f32x4*)(wc_ + DFF + ch);
#pragma unroll
            for (int j = 0; j < 4; ++j) { va[j] += wa[j] * bf2f(xa[j]); vg[j] += wg[j] * bf2f(xg[j]); }
        }
        if (hn) {
            const u16x4 xa = *(const u16x4*)(rn + ch), xg = *(const u16x4*)(rn + DFF + ch);
            const f32x4 wa = *(const f32x4*)(wc_ + 2 * DFF2 + ch), wg = *(const f32x4*)(wc_ + 2 * DFF2 + DFF + ch);
#pragma unroll
            for (int j = 0; j < 4; ++j) { va[j] += wa[j] * bf2f(xa[j]); vg[j] += wg[j] * bf2f(xg[j]); }
        }
        f32x4 o;
#pragma unroll
        for (int j = 0; j < 4; ++j) o[j] = siluf_(vg[j]) * va[j];
        store_bf4(act + (size_t)R * DFF + ch, o);
    }
    asm volatile("s_waitcnt vmcnt(0)" ::: "memory");
    __syncthreads();
}

DEV bf16x8 frag4(unsigned a, unsigned b, unsigned c, unsigned d) { u32x4 v; v[0] = a; v[1] = b; v[2] = c; v[3] = d; return __builtin_bit_cast(bf16x8, v); }
DEV bf16x8 ld16(const bf16_t* p) { return *(const bf16x8*)p; }
DEV u32x2 ld8(const bf16_t* p) { return *(const u32x2*)p; }
#define MFMA16(a, b, c) __builtin_amdgcn_mfma_f32_16x16x32_bf16(a, b, c, 0, 0, 0)

DEV void scan_ret_mfma(KP p, int l, int it, unsigned char* lds) {
    const int tid0 = otid();
    int s, head, dir, sl;
    if (it < 64) { s = 16 + (it >> 4); head = (it >> 2) & 3; dir = (it >> 1) & 1; sl = it & 1; }
    else { const int k = it - 64; s = k >> 4; head = (k >> 2) & 3; dir = (k >> 1) & 1; sl = k & 1; }
    const int row0 = seq_row0(s), T = seq_len(s);
    bf16_t* Qs = (bf16_t*)lds;
    bf16_t* Ks = Qs + 64 * 264;
    bf16_t* Kt = Ks + 64 * 264;
    bf16_t* Vt = Kt + 256 * 72;
    bf16_t* Ps = Vt + 256 * 72;
    float* gp = (float*)(Ps + 64 * 72);
    const bf16_t* qb = (const bf16_t*)(p->ws + OFF_QB);
    const bf16_t* kb = (const bf16_t*)(p->ws + OFF_KB);
    const bf16_t* vb = (const bf16_t*)(p->ws + OFF_VB);
    bf16_t* oo = (bf16_t*)(p->ws + (dir ? OFF_OBB : OFF_OBF));
    const float gamma = 1.f - exp2f(-(5.f + (dir ? 0.5f : 0.f)) - (float)head);
    const float lg2 = log2f(gamma);
    bf16x8 pq[4], pk[4], pv[4];
#define RET_ISSUE_QK(cc) do { const int tq_ = tid >> 5, c8_ = tid & 31; _Pragma("unroll") for (int i = 0; i < 4; ++i) { const int j = 4 * tq_ + i, tok = dir ? (T - 1 - ((cc) + j)) : ((cc) + j); \
        const size_t g = (size_t)(row0 + tok) * 1024 + head * 256 + c8_ * 8; pq[i] = *(const bf16x8*)(qb + g); pk[i] = *(const bf16x8*)(kb + g); } } while (0)
#define RET_ISSUE_V(cc) do { const int tq_ = tid >> 5, c8_ = tid & 31; _Pragma("unroll") for (int i = 0; i < 4; ++i) { const int j = 4 * tq_ + i, tok = dir ? (T - 1 - ((cc) + j)) : ((cc) + j); \
        pv[i] = *(const bf16x8*)(vb + (size_t)(row0 + tok) * 2048 + head * 512 + sl * 256 + 8 * c8_); } } while (0)
    { const int tid = tid0; RET_ISSUE_QK(0); RET_ISSUE_V(0); }
    __syncthreads();
    if (tid0 < 65) gp[tid0] = exp2f((float)tid0 * lg2);
    f32x4 S[16][2];
    {
        const int w = tid0 >> 6, fr = tid0 & 15, fq = (tid0 >> 4) & 3;
        if (s >= 16) {
            const float* st = p->state_ret + ((((size_t)(s - 16) * 2 + l) * 2 + dir) * 4 + head) * 256 * 512 + sl * 256 + 32 * w + 8 * (fr >> 2) + (fr & 3);
#pragma unroll
            for (int dt = 0; dt < 16; ++dt)
#pragma unroll
                for (int dvt = 0; dvt < 2; ++dvt)
#pragma unroll
                    for (int jj = 0; jj < 4; ++jj) S[dt][dvt][jj] = st[(size_t)(16 * dt + 4 * fq + jj) * 512 + 4 * dvt];
        } else {
#pragma unroll
            for (int dt = 0; dt < 16; ++dt) { S[dt][0] = (f32x4){0.f, 0.f, 0.f, 0.f}; S[dt][1] = (f32x4){0.f, 0.f, 0.f, 0.f}; }
        }
    }
    for (int c0 = 0; c0 < T; c0 += 64) {
        int tid = tid0; asm volatile("" : "+v"(tid));
        const int w = tid >> 6, lane = tid & 63, fr = lane & 15, fq = lane >> 4, tq = tid >> 5, c8 = tid & 31;
        __syncthreads();
        {
            const float g0 = gp[63 - 4 * tq], g1 = gp[62 - 4 * tq], g2 = gp[61 - 4 * tq], g3 = gp[60 - 4 * tq];
#pragma unroll
            for (int i = 0; i < 4; ++i) { *(bf16x8*)(Qs + (4 * tq + i) * 264 + c8 * 8) = pq[i]; *(bf16x8*)(Ks + (4 * tq + i) * 264 + c8 * 8) = pk[i]; }
            const int kpos = 8 * ((tq >> 1) ^ (c8 & 7)) + 4 * (tq & 1);
#pragma unroll
            for (int c = 0; c < 8; ++c) {
                u32x2 o;
                o[0] = pk2(bf2f((bf16_t)pk[0][c]) * g0, bf2f((bf16_t)pk[1][c]) * g1);
                o[1] = pk2(bf2f((bf16_t)pk[2][c]) * g2, bf2f((bf16_t)pk[3][c]) * g3);
                *(u32x2*)(Kt + (c8 * 8 + c) * 72 + kpos) = o;
                if (c & 1) __builtin_amdgcn_sched_barrier(0);
            }
#pragma unroll
            for (int c = 0; c < 8; ++c) {
                u32x2 o;
                o[0] = (unsigned)(bf16_t)pv[0][c] | ((unsigned)(bf16_t)pv[1][c] << 16);
                o[1] = (unsigned)(bf16_t)pv[2][c] | ((unsigned)(bf16_t)pv[3][c] << 16);
                *(u32x2*)(Vt + (c8 * 8 + c) * 72 + kpos) = o;
                if (c & 1) __builtin_amdgcn_sched_barrier(0);
            }
        }
        __syncthreads();
#pragma unroll
        for (int h = 0; h < 2; ++h) {
            const int idx = w + 8 * h, ti = idx >> 2, tj = idx & 3;
            f32x4 acc = (f32x4){0.f, 0.f, 0.f, 0.f};
            if (tj <= ti) {
#pragma unroll
                for (int ks = 0; ks < 8; ++ks)
                    acc = MFMA16(ld16(Ks + (16 * tj + fr) * 264 + 32 * ks + 8 * fq), ld16(Qs + (16 * ti + fr) * 264 + 32 * ks + 8 * fq), acc);
                const int i = 16 * ti + fr, j0 = 16 * tj + 4 * fq;
#pragma unroll
                for (int jj = 0; jj < 4; ++jj) { const int d = i - (j0 + jj); acc[jj] = d >= 0 ? acc[jj] * gp[d >= 0 ? d : 0] : 0.f; }
            }
            u32x2 o; o[0] = pk2(acc[0], acc[1]); o[1] = pk2(acc[2], acc[3]);
            *(u32x2*)(Ps + (16 * ti + fr) * 72 + 16 * tj + 4 * fq) = o;
        }
        __syncthreads();
        const int dv0 = 32 * w + 8 * (fr >> 2) + (fr & 3), dv1 = dv0 + 4;
        const int vsw0 = (dv0 >> 3) & 7, vsw1 = (dv1 >> 3) & 7;
        const bf16_t* vrow0 = Vt + dv0 * 72; const bf16_t* vrow1 = Vt + dv1 * 72;
        const bf16x8 vf00 = ld16(vrow0 + 8 * (fq ^ vsw0)), vf01 = ld16(vrow0 + 8 * ((4 + fq) ^ vsw0));
        const bf16x8 vf10 = ld16(vrow1 + 8 * (fq ^ vsw1)), vf11 = ld16(vrow1 + 8 * ((4 + fq) ^ vsw1));
        {
            f32x4 o[4][2];
#pragma unroll
            for (int tt = 0; tt < 4; ++tt) { o[tt][0] = (f32x4){0.f, 0.f, 0.f, 0.f}; o[tt][1] = (f32x4){0.f, 0.f, 0.f, 0.f}; }
            const bf16_t* qbase = Qs + fr * 264 + 4 * fq;
#pragma unroll
            for (int q = 0; q < 8; ++q) {
                const bf16x8 sf0 = frag4(pk2(S[2 * q][0][0], S[2 * q][0][1]), pk2(S[2 * q][0][2], S[2 * q][0][3]), pk2(S[2 * q + 1][0][0], S[2 * q + 1][0][1]), pk2(S[2 * q + 1][0][2], S[2 * q + 1][0][3]));
                const bf16x8 sf1 = frag4(pk2(S[2 * q][1][0], S[2 * q][1][1]), pk2(S[2 * q][1][2], S[2 * q][1][3]), pk2(S[2 * q + 1][1][0], S[2 * q + 1][1][1]), pk2(S[2 * q + 1][1][2], S[2 * q + 1][1][3]));
#pragma unroll
                for (int tt = 0; tt < 4; ++tt) {
                    const u32x2 b0 = ld8(qbase + 16 * tt * 264 + 32 * q), b1 = ld8(qbase + 16 * tt * 264 + 32 * q + 16);
                    const bf16x8 bq = frag4(b0[0], b0[1], b1[0], b1[1]);
                    o[tt][0] = MFMA16(sf0, bq, o[tt][0]);
                    o[tt][1] = MFMA16(sf1, bq, o[tt][1]);
                }
                __builtin_amdgcn_sched_barrier(0);
            }
            const bf16_t* pbase = Ps + fr * 72 + 8 * fq;
            const float* gbase = gp + fr + 1;
            const int i0 = c0 + fr;
#pragma unroll
            for (int tt = 0; tt < 4; ++tt) {
                const float sc = gbase[16 * tt];
                o[tt][0] = o[tt][0] * sc; o[tt][1] = o[tt][1] * sc;
                const bf16x8 p0 = ld16(pbase + 16 * tt * 72), p1 = ld16(pbase + 16 * tt * 72 + 32);
                o[tt][0] = MFMA16(vf00, p0, o[tt][0]); o[tt][0] = MFMA16(vf01, p1, o[tt][0]);
                o[tt][1] = MFMA16(vf10, p0, o[tt][1]); o[tt][1] = MFMA16(vf11, p1, o[tt][1]);
                const int pos = i0 + 16 * tt, tok = dir ? (T - 1 - pos) : pos;
                bf16_t* op = oo + (size_t)(row0 + tok) * 2048 + head * 512 + sl * 256 + 32 * w + 8 * fq;
                u32x4 ov; ov[0] = pk2(o[tt][0][0], o[tt][0][1]); ov[1] = pk2(o[tt][0][2], o[tt][0][3]); ov[2] = pk2(o[tt][1][0], o[tt][1][1]); ov[3] = pk2(o[tt][1][2], o[tt][1][3]);
                *(u32x4*)op = ov;
                __builtin_amdgcn_sched_barrier(0);
            }
        }
        __builtin_amdgcn_sched_barrier(0);
        if (c0 + 64 < T) RET_ISSUE_QK(c0 + 64);
        __builtin_amdgcn_sched_barrier(0);
        {
            const float g64 = gp[64];
            const bf16_t* kbase = Kt + fr * 72;
            const int kswb = (fr >> 3) & 1;
#pragma unroll
            for (int dt = 0; dt < 16; ++dt) {
                const int ksw = (2 * dt + kswb) & 7;
                const bf16x8 k0 = ld16(kbase + 16 * dt * 72 + 8 * (fq ^ ksw)), k1 = ld16(kbase + 16 * dt * 72 + 8 * ((4 + fq) ^ ksw));
                S[dt][0] = S[dt][0] * g64; S[dt][1] = S[dt][1] * g64;
                S[dt][0] = MFMA16(k0, vf00, S[dt][0]); S[dt][0] = MFMA16(k1, vf01, S[dt][0]);
                S[dt][1] = MFMA16(k0, vf10, S[dt][1]); S[dt][1] = MFMA16(k1, vf11, S[dt][1]);
                if (dt & 1) __builtin_amdgcn_sched_barrier(0);
            }
        }
        if (c0 + 64 < T) RET_ISSUE_V(c0 + 64);
    }
#undef RET_ISSUE_QK
#undef RET_ISSUE_V
    if (s < 16) {
        const int w = tid0 >> 6, fr = tid0 & 15, fq = (tid0 >> 4) & 3;
        float* st = p->out + OUT_SR + ((((size_t)s * 2 + l) * 2 + dir) * 4 + head) * 256 * 512 + sl * 256 + 32 * w + 8 * (fr >> 2) + (fr & 3);
#pragma unroll
        for (int dt = 0; dt < 16; ++dt)
#pragma unroll
            for (int dvt = 0; dvt < 2; ++dvt)
#pragma unroll
                for (int jj = 0; jj < 4; ++jj) st[(size_t)(16 * dt + 4 * fq + jj) * 512 + 4 * dvt] = S[dt][dvt][jj];
    }
}

DEV void scan_hgrn_mfma(KP p, int l, int it, unsigned char* lds) {
    const int tid = otid(), w = tid >> 6, lane = tid & 63, fr = lane & 15, fq = lane >> 4;
    int s, head, dir;
    if (it < 64) { s = 16 + (it >> 4); head = (it >> 1) & 7; dir = it & 1; }
    else { const int k = it - 64; s = k >> 4; head = (k >> 1) & 7; dir = k & 1; }
    const int row0 = seq_row0(s), T = seq_len(s);
    bf16_t* Qd = (bf16_t*)lds;
    bf16_t* Kn = Qd + 4 * 16 * 136;
    bf16_t* Kdt = Kn + 4 * 16 * 136;
    bf16_t* Vt = Kdt + 4 * 128 * 24;
    float* ae = (float*)(Vt + 4 * 128 * 24);
    const float* lfp = (const float*)(p->ws + (dir ? OFF_LFB : OFF_LFF));
    const bf16_t* qa = (const bf16_t*)(p->ws + OFF_QA);
    const bf16_t* ia = (const bf16_t*)(p->ws + OFF_IA);
    bf16_t* oo = (bf16_t*)(p->ws + (dir ? OFF_OAB : OFF_OAF));
    const int d = tid & 127, sub = tid >> 7;
    float plf[16]; bf16_t pqv[16], pvv[16];
#define HG_ISSUE(cc) do { _Pragma("unroll") for (int i = 0; i < 16; ++i) { const int pos = (cc) + 16 * sub + i, tok = dir ? (T - 1 - pos) : pos; \
        const size_t g = (size_t)(row0 + tok) * 1024 + head * 128 + d; plf[i] = lfp[g]; pqv[i] = qa[g]; pvv[i] = ia[g]; } } while (0)
    HG_ISSUE(0);
    f32x4 S[8];
    if (s >= 16) {
        const float* st = p->state_hgrn + ((((size_t)(s - 16) * 2 + l) * 2 + dir) * 8 + head) * 128 * 128 + 16 * w + fr;
#pragma unroll
        for (int dt = 0; dt < 8; ++dt)
#pragma unroll
            for (int jj = 0; jj < 4; ++jj) S[dt][jj] = st[(size_t)(16 * dt + 4 * fq + jj) * 128];
    } else {
#pragma unroll
        for (int dt = 0; dt < 8; ++dt) S[dt] = (f32x4){0.f, 0.f, 0.f, 0.f};
    }
    for (int c0 = 0; c0 < T; c0 += 64) {
        __syncthreads();
        {
            float cum = 0.f;
            float kn[16];
            unsigned vpk[8], kpk[8];
#pragma unroll
            for (int i = 0; i < 16; ++i) {
                const float lf = plf[i] * 1.4426950408889634f;
                cum += lf;
                const float k = 1.f - __builtin_amdgcn_exp2f(lf), q = bf2f(pqv[i]);
                const unsigned v = pvv[i];
                const float ec = __builtin_amdgcn_exp2f(fmaxf(cum, -100.f)), en = __builtin_amdgcn_rcpf(ec);
                Qd[(sub * 16 + i) * 136 + d] = f2bf(q * ec);
                kn[i] = k * en;
                Kn[(sub * 16 + i) * 136 + d] = f2bf(kn[i]);
                if (i & 1) vpk[i >> 1] |= v << 16; else vpk[i >> 1] = v;
            }
            const float aend = __builtin_amdgcn_exp2f(fmaxf(cum, -100.f));
            ae[sub * 128 + d] = aend;
#pragma unroll
            for (int i = 0; i < 8; ++i) kpk[i] = pk2(kn[2 * i] * aend, kn[2 * i + 1] * aend);
            u32x4 t0, t1;
            t0[0] = kpk[0]; t0[1] = kpk[1]; t0[2] = kpk[2]; t0[3] = kpk[3]; t1[0] = kpk[4]; t1[1] = kpk[5]; t1[2] = kpk[6]; t1[3] = kpk[7];
            *(u32x4*)(Kdt + (sub * 128 + d) * 24) = t0; *(u32x4*)(Kdt + (sub * 128 + d) * 24 + 8) = t1;
            t0[0] = vpk[0]; t0[1] = vpk[1]; t0[2] = vpk[2]; t0[3] = vpk[3]; t1[0] = vpk[4]; t1[1] = vpk[5]; t1[2] = vpk[6]; t1[3] = vpk[7];
            *(u32x4*)(Vt + (sub * 128 + d) * 24) = t0; *(u32x4*)(Vt + (sub * 128 + d) * 24 + 8) = t1;
        }
        if (c0 + 64 < T) HG_ISSUE(c0 + 64);
        __syncthreads();
#pragma unroll
        for (int sc = 0; sc < 4; ++sc) {
            const bf16_t* qd = Qd + sc * 16 * 136; const bf16_t* knp = Kn + sc * 16 * 136;
            const bf16_t* kdt = Kdt + sc * 128 * 24; const bf16_t* vt = Vt + sc * 128 * 24;
            f32x4 pa = (f32x4){0.f, 0.f, 0.f, 0.f};
#pragma unroll
            for (int ks = 0; ks < 4; ++ks) pa = MFMA16(ld16(knp + fr * 136 + 32 * ks + 8 * fq), ld16(qd + fr * 136 + 32 * ks + 8 * fq), pa);
#pragma unroll
            for (int jj = 0; jj < 4; ++jj) pa[jj] = (4 * fq + jj <= fr) ? pa[jj] : 0.f;
            const bf16x8 pb = frag4(pk2(pa[0], pa[1]), pk2(pa[2], pa[3]), 0u, 0u);
            f32x4 o = (f32x4){0.f, 0.f, 0.f, 0.f};
#pragma unroll
            for (int q = 0; q < 4; ++q) {
                const bf16x8 sf = frag4(pk2(S[2 * q][0], S[2 * q][1]), pk2(S[2 * q][2], S[2 * q][3]), pk2(S[2 * q + 1][0], S[2 * q + 1][1]), pk2(S[2 * q + 1][2], S[2 * q + 1][3]));
                const u32x2 b0 = ld8(qd + fr * 136 + 32 * q + 4 * fq), b1 = ld8(qd + fr * 136 + 32 * q + 16 + 4 * fq);
                o = MFMA16(sf, frag4(b0[0], b0[1], b1[0], b1[1]), o);
            }
            {
                const u32x2 va = ld8(vt + (16 * w + fr) * 24 + 4 * fq);
                o = MFMA16(frag4(va[0], va[1], 0u, 0u), pb, o);
            }
            {
                const int pos = c0 + 16 * sc + fr, tok = dir ? (T - 1 - pos) : pos;
                u32x2 ov; ov[0] = pk2(o[0], o[1]); ov[1] = pk2(o[2], o[3]);
                *(u32x2*)(oo + (size_t)(row0 + tok) * 1024 + head * 128 + 16 * w + 4 * fq) = ov;
            }
            bf16x8 vf = frag4(0u, 0u, 0u, 0u);
            if (fq < 2) vf = ld16(vt + (16 * w + fr) * 24 + 8 * fq);
#pragma unroll
            for (int dt = 0; dt < 8; ++dt) {
                const f32x4 a4 = *(const f32x4*)(ae + sc * 128 + 16 * dt + 4 * fq);
                S[dt] = S[dt] * a4;
                bf16x8 kf = frag4(0u, 0u, 0u, 0u);
                if (fq < 2) kf = ld16(kdt + (16 * dt + fr) * 24 + 8 * fq);
                S[dt] = MFMA16(kf, vf, S[dt]);
            }
        }
    }
#undef HG_ISSUE
    if (s < 16) {
        float* st = p->out + OUT_SH + ((((size_t)s * 2 + l) * 2 + dir) * 8 + head) * 128 * 128 + 16 * w + fr;
#pragma unroll
        for (int dt = 0; dt < 8; ++dt)
#pragma unroll
            for (int jj = 0; jj < 4; ++jj) st[(size_t)(16 * dt + 4 * fq + jj) * 128] = S[dt][jj];
    }
}

DEV void phase_scan(KP p, int l, float* lds, int qi) {
    p = fresh(p);
    unsigned* qctr = (unsigned*)(p->ws + OFF_BAR) + 3520 + 64 * qi;
    volatile LAS3 unsigned* bc = (volatile LAS3 unsigned*)((LAS3 unsigned char*)lds + LDS_BYTES - 8);
    for (;;) {
        __syncthreads();
        if (otid() == 0) *bc = xb_add(qctr, 1u);
        __syncthreads();
        const int it = (int)*bc;
        if (it >= (l == 0 ? 1476 : 1412)) break;
        if (it < 64) scan_ret_mfma(p, l, it, (unsigned char*)lds);
        else if (it < 128) scan_hgrn_mfma(p, l, it - 64, (unsigned char*)lds);
        else if (it < 768) {
            unsigned char* ws = p->ws;
            EpiInProj E{ws, l};
            Prog S = prog_plain((const bf16_t*)(ws + OFF_H), (const bf16_t*)(ws + OFF_WIN), 1024, 1024, 1024);
            S.pnmap = 2;
            gemm_one(S, 32, 20, it - 128, E, (bf16_t*)lds);
        }
        else if (it < 1024) scan_ret_mfma(p, l, it - 768 + 64, (unsigned char*)lds);
        else if (it < 1280) scan_hgrn_mfma(p, l, it - 1024 + 64, (unsigned char*)lds);
        else {
#pragma unroll 1
            for (int k = 0; k < 4; ++k) convert_tile(p, l, (l == 0 ? 832 : 1088) + 4 * (it - 1280) + k, lds);
        }
    }
    __syncthreads();
}

DEV void phase_combine(KP p) {
    p = fresh(p);
    const int tid = otid(), wid = tid >> 6, lane = tid & 63;
    const bf16_t* oaf = (const bf16_t*)(p->ws + OFF_OAF); const bf16_t* oab = (const bf16_t*)(p->ws + OFF_OAB);
    const bf16_t* obf = (const bf16_t*)(p->ws + OFF_OBF); const bf16_t* obb = (const bf16_t*)(p->ws + OFF_OBB);
    const bf16_t* ga = (const bf16_t*)(p->ws + OFF_GA); const bf16_t* gb = (const bf16_t*)(p->ws + OFF_GB);
    bf16_t* oa = (bf16_t*)(p->ws + OFF_OA); bf16_t* ob = (bf16_t*)(p->ws + OFF_OB);
    const int stride = gridDim.x * 8;
    for (int row0 = blockIdx.x * 8 + wid; row0 < NTOK; row0 += 2 * stride) {
        u16x8 af[2][2], ab[2][2], ag[2][2], bf[2][4], bb[2][4], bg[2][4];
#pragma unroll
        for (int r = 0; r < 2; ++r) {
            const int row = row0 + r * stride;
            if (row < NTOK) {
                const size_t ba = (size_t)row * 1024 + lane * 16, bbs = (size_t)row * 2048 + lane * 32;
#pragma unroll
                for (int h8 = 0; h8 < 2; ++h8) { af[r][h8] = *(const u16x8*)(oaf + ba + h8 * 8); ab[r][h8] = *(const u16x8*)(oab + ba + h8 * 8); ag[r][h8] = *(const u16x8*)(ga + ba + h8 * 8); }
#pragma unroll
                for (int h8 = 0; h8 < 4; ++h8) { bf[r][h8] = *(const u16x8*)(obf + bbs + h8 * 8); bb[r][h8] = *(const u16x8*)(obb + bbs + h8 * 8); bg[r][h8] = *(const u16x8*)(gb + bbs + h8 * 8); }
            }
        }
#pragma unroll
        for (int r = 0; r < 2; ++r) {
            const int row = row0 + r * stride;
            if (row < NTOK) {
                {
                    const size_t base = (size_t)row * 1024 + lane * 16;
                    float o[16]; float ss = 0.f;
#pragma unroll
                    for (int h8 = 0; h8 < 2; ++h8)
#pragma unroll
                        for (int i = 0; i < 8; ++i) { o[h8 * 8 + i] = bf2f(af[r][h8][i]) + bf2f(ab[r][h8][i]); ss += o[h8 * 8 + i] * o[h8 * 8 + i]; }
                    ss += shfl_xor_l(ss, 1, lane); ss += shfl_xor_l(ss, 2, lane); ss += shfl_xor_l(ss, 4, lane);
                    const float rstd = rsqrtf(ss * (1.f / 128.f) + EPS);
#pragma unroll
                    for (int h8 = 0; h8 < 2; ++h8) {
                        u32x4 rr;
#pragma unroll
                        for (int i = 0; i < 4; ++i) rr[i] = pk2(o[h8 * 8 + 2 * i] * rstd * siluf_(bf2f(ag[r][h8][2 * i])), o[h8 * 8 + 2 * i + 1] * rstd * siluf_(bf2f(ag[r][h8][2 * i + 1])));
                        *(u32x4*)(oa + base + h8 * 8) = rr;
                    }
                }
                {
                    const size_t base = (size_t)row * 2048 + lane * 32;
                    float o[32]; float ss = 0.f;
#pragma unroll
                    for (int h8 = 0; h8 < 4; ++h8)
#pragma unroll
                        for (int i = 0; i < 8; ++i) { o[h8 * 8 + i] = bf2f(bf[r][h8][i]) + bf2f(bb[r][h8][i]); ss += o[h8 * 8 + i] * o[h8 * 8 + i]; }
                    ss += shfl_xor_l(ss, 1, lane); ss += shfl_xor_l(ss, 2, lane); ss += shfl_xor_l(ss, 4, lane); ss += shfl_xor_l(ss, 8, lane);
                    const float rstd = rsqrtf(ss * (1.f / 512.f) + EPS);
#pragma unroll
                    for (int h8 = 0; h8 < 4; ++h8) {
                        u32x4 rr;
#pragma unroll
                        for (int i = 0; i < 4; ++i) rr[i] = pk2(o[h8 * 8 + 2 * i] * rstd * siluf_(bf2f(bg[r][h8][2 * i])), o[h8 * 8 + 2 * i + 1] * rstd * siluf_(bf2f(bg[r][h8][2 * i + 1])));
                        *(u32x4*)(ob + base + h8 * 8) = rr;
                    }
                }
            }
        }
    }
}

DEV void phase_convact(KP p, int l) {
    p = fresh(p);
    const bf16_t* u = (const bf16_t*)(p->ws + OFF_U);
    bf16_t* act = (bf16_t*)(p->ws + OFF_ACT);
    const float* wc = p->w_conv + (size_t)l * 3 * DFF2;
    const float* bc = p->b_conv + (size_t)l * DFF2;
    const int total = NTOK * (DFF / 8);
    for (int i = blockIdx.x * NTHR + otid(); i < total; i += gridDim.x * NTHR) {
        const int row = i / (DFF / 8), f = (i % (DFF / 8)) * 8;
        int t, T;
        if (row < NCTX) { t = row & 255; T = 256; } else { t = (row - NCTX) & 1023; T = 1024; }
        float ca[8], cgv[8];
#pragma unroll
        for (int k = 0; k < 8; ++k) { ca[k] = bc[f + k]; cgv[k] = bc[DFF + f + k]; }
#pragma unroll
        for (int dt = -1; dt <= 1; ++dt) {
            if (t + dt < 0 || t + dt >= T) continue;
            const bf16_t* ur = u + (size_t)(row + dt) * DFF2;
            const u16x8 ua = *(const u16x8*)(ur + f), ug = *(const u16x8*)(ur + DFF + f);
            const float* w = wc + (dt + 1) * DFF2;
#pragma unroll
            for (int k = 0; k < 8; ++k) { ca[k] += bf2f(ua[k]) * w[f + k]; cgv[k] += bf2f(ug[k]) * w[DFF + f + k]; }
        }
        u16x8 r;
#pragma unroll
        for (int k = 0; k < 8; ++k) r[k] = f2bf(siluf_(cgv[k]) * ca[k]);
        *(u16x8*)(act + (size_t)row * DFF + f) = r;
    }
}

#define XB_TMO      128
#define XB_XCNT(j)  (256  + 64 * (j))
#define XB_XSUB(j)  (1280 + 64 * (j))
#define XB_XGEN(j)  (2304 + 64 * (j))
#define XB_TOP      3328
#define XB_TOPGEN   3392
#define XCD_BAR_WORDS 3456
#define XB_SPIN_CAP (1u << 18)
DEV unsigned xb_ld(unsigned* p) { return __hip_atomic_load(p, __ATOMIC_RELAXED, __HIP_MEMORY_SCOPE_AGENT); }
DEV unsigned xb_xcc_id() { return (unsigned)__builtin_amdgcn_s_getreg((3 << 11) | 20) & 0xFu; }
#define XB_SPIN(cond, bar) do { unsigned _sp = 0; while (cond) { __builtin_amdgcn_s_sleep(1); \
    if ((++_sp & 255u) == 0u) { if (xb_ld(&(bar)[XB_TMO])) break; if (_sp > XB_SPIN_CAP) { (void)xb_add(&(bar)[XB_TMO], 1u); break; } } } } while (0)
struct XcdBarrier { KP kp; volatile LAS3 unsigned* st; };
DEV XcdBarrier xcd_barrier_post(KP kp, volatile LAS3 unsigned* st) {
    XcdBarrier b; b.kp = kp; b.st = st;
    unsigned* bar = (unsigned*)(kp->ws + OFF_BAR);
    if (threadIdx.x == 0) (void)xb_add(&bar[XB_XCNT(xb_xcc_id())], 1u);
    return b;
}
DEV void xcd_barrier_complete(unsigned* bar, unsigned x, unsigned& nloc, unsigned& nx) {
    const unsigned G = gridDim.x * gridDim.y * gridDim.z;
    unsigned sum, cnt, mine, sp = 0u;
    for (;;) {
        sum = 0u; cnt = 0u; mine = 0u;
#pragma unroll
        for (unsigned j = 0; j < 16; ++j) { const unsigned c = xb_ld(&bar[XB_XCNT(j)]); sum += c; cnt += (c > 0u) ? 1u : 0u; mine = (j == x) ? c : mine; }
        if (sum == G) break;
        __builtin_amdgcn_s_sleep(1);
        if ((++sp & 255u) == 0u) { if (xb_ld(&bar[XB_TMO])) break; if (sp > XB_SPIN_CAP) { (void)xb_add(&bar[XB_TMO], 1u); break; } }
    }
    nloc = mine > 0u ? mine : 1u; nx = cnt > 0u ? cnt : 1u;
}
DEV void xcd_barrier(const XcdBarrier& b) {
    asm volatile("s_waitcnt vmcnt(0)" ::: "memory");
    __syncthreads();
    if (threadIdx.x == 0) {
        unsigned* bar = (unsigned*)(fresh(b.kp)->ws + OFF_BAR);
        const unsigned bx = xb_xcc_id();
        __builtin_amdgcn_s_waitcnt(0);
        unsigned nloc = b.st[0], nx = b.st[1];
        if (nloc == 0u) { xcd_barrier_complete(bar, bx, nloc, nx); b.st[0] = nloc; b.st[1] = nx; }
        const unsigned old = xb_add(&bar[XB_XSUB(bx)], 1u);
        const unsigned gen = old / nloc;
        if (old + 1u == (gen + 1u) * nloc) {
            __builtin_amdgcn_fence(__ATOMIC_RELEASE, "agent");
            asm volatile("s_waitcnt vmcnt(0)" ::: "memory");
            const unsigned og = xb_add(&bar[XB_TOP], 1u);
            const unsigned tg = og / nx;
            if (og + 1u == (tg + 1u) * nx) xb_add(&bar[XB_TOPGEN], 1u);
            else XB_SPIN(xb_ld(&bar[XB_TOPGEN]) == tg, bar);
            __builtin_amdgcn_fence(__ATOMIC_ACQUIRE, "agent");
            xb_add(&bar[XB_XGEN(bx)], 1u);
            asm volatile("s_waitcnt vmcnt(0)" ::: "memory");
        } else {
            XB_SPIN(xb_ld(&bar[XB_XGEN(bx)]) == gen, bar);
            __builtin_amdgcn_fence(__ATOMIC_ACQUIRE, "agent");
            asm volatile("s_waitcnt vmcnt(0)" ::: "memory");
        }
    }
    __syncthreads();
}

#ifndef SKIP_MODS
#define RUN_MODS(x) x
#else
#define RUN_MODS(x)
#endif
#ifndef SKIP_CONV
#define RUN_CONV(x) x
#else
#define RUN_CONV(x)
#endif
#ifndef SKIP_NORM
#define RUN_NORM(x) x
#else
#define RUN_NORM(x)
#endif
#if defined(DUP_GEMM)
#define RUN_GEMM(x) x x
#elif !defined(SKIP_GEMM)
#define RUN_GEMM(x) x
#else
#define RUN_GEMM(x)
#endif
#if defined(DUP_SCAN)
#define RUN_SCAN(x) x x
#elif !defined(SKIP_SCAN)
#define RUN_SCAN(x) x
#else
#define RUN_SCAN(x)
#endif
#ifndef SKIP_COMB
#define RUN_COMB(x) x
#else
#define RUN_COMB(x)
#endif
#ifndef SKIP_ACT
#define RUN_ACT(x) x
#else
#define RUN_ACT(x)
#endif
__global__ void __launch_bounds__(NTHR) fwd_megakernel(Params p_unused) {
    cg::grid_group grid = cg::this_grid();
    extern __shared__ __attribute__((aligned(16))) unsigned char smem[];
    float* ldsf = (float*)smem;
    bf16_t* ldsh = (bf16_t*)smem;
    KP kp = (KP)__builtin_amdgcn_kernarg_segment_ptr();
    volatile LAS3 unsigned* xst = (volatile LAS3 unsigned*)((LAS3 unsigned char*)smem + LDS_BYTES - 16);
    if (threadIdx.x == 0) { xst[0] = 0u; xst[1] = 0u; }
    __syncthreads();
    const XcdBarrier xb = xcd_barrier_post(kp, xst);

    RUN_MODS(phase_mods(kp, ldsf);)
    RUN_CONV(phase_convert(kp, 0, ldsf);)
    if (kp->ws == nullptr) grid.sync();
    xcd_barrier(xb);
#pragma unroll 1
    for (int l = 0; l < 2; ++l) {
        if (l == 0) { RUN_NORM(phase_norm(kp, 0, 0, 0, 0, 1, 0);) }
        else { RUN_CONV(convert_queue(kp, ldsf, 0, 0, 1088, 1 << 20);) RUN_NORM(phase_norm(kp, 1, 1, 1,   0 * 8 + 5, 1, 0);) }
        xcd_barrier(xb);
        {
            unsigned char* ws = fresh(kp)->ws;
            EpiInProj E{ws, l};
            Prog S = prog_plain((const bf16_t*)(ws + OFF_H), (const bf16_t*)(ws + OFF_WIN), 1024, 1024, 1024);
            S.pnmap = 1;
            RUN_GEMM(gemm_run(S, 32, 32, E, ldsh);)
        }
        xcd_barrier(xb);
        RUN_SCAN(phase_scan(kp, l, ldsf, l);)
#ifdef DUP_SCAN2
        phase_scan(kp, l, ldsf, l + 2);
#endif
        xcd_barrier(xb);
        RUN_COMB(phase_combine(kp);)
        xcd_barrier(xb);
        {
            unsigned char* ws = fresh(kp)->ws;
            Prog S = prog_plain((const bf16_t*)(ws + OFF_OA), (const bf16_t*)(ws + OFF_PA), 1024, 1024, 1024);
            S.A1 = (const bf16_t*)(ws + OFF_OB); S.B1 = (const bf16_t*)(ws + OFF_PB); S.lda1 = 2048; S.ldb1 = 2048; S.K1a = 512; S.K1b = 1536; S.mode = 1; S.ks = 2;
            EpiMerged E{ws};
            RUN_GEMM(gemm_run(S, 32, 4, E, ldsh);)
        }
        xcd_barrier(xb);
        {
            unsigned char* ws = fresh(kp)->ws;
            Prog S = prog_plain((const bf16_t*)(ws + OFF_MERGED), (const bf16_t*)(ws + OFF_WOUT), 1024, 1024, 1024);
            S.A1 = (const bf16_t*)(ws + OFF_MERGED) + (size_t)NTOK * 1024; S.ks = 2; S.bsame = 1;
            EpiBf E{(bf16_t*)(ws + OFF_P), (bf16_t*)(ws + OFF_P1), 1024};
            RUN_GEMM(gemm_run(S, 32, 4, E, ldsh);)
        }
        xcd_barrier(xb);
        RUN_NORM(phase_norm(kp, 1, 2 + l, l, l * 8 + 2, 4, 3);)
        xcd_barrier(xb);
        {
            KP pp = fresh(kp);
            unsigned char* ws = pp->ws;
            EpiUpConv E{ws, pp->w_conv + (size_t)l * 3 * DFF2, pp->b_conv + (size_t)l * DFF2};
            RUN_GEMM(gemm_run(prog_plain((const bf16_t*)(ws + OFF_H), (const bf16_t*)(ws + OFF_WUP), 1024, 1024, 1024), 32, 22, E, ldsh);)
        }
        if (l == 0 && (int)blockIdx.x + 2 * (int)gridDim.x >= 704) { RUN_CONV(convert_queue(kp, ldsf, 0, 0, 1088, 9);) }
        xcd_barrier(xb);
        {
            KP pp = fresh(kp);
            unsigned char* ws = pp->ws;
            Prog S = prog_plain((const bf16_t*)(ws + OFF_ACT), (const bf16_t*)(ws + OFF_WDN), DFF, DFF, DFF / 2);
            S.ks = 2;
            for (int u = blockIdx.x; u < 256; u += gridDim.x) {
                S.nM = 32; S.nN = 4; S.nwg = 128;
                int fpm, fpn; S.tile_of(u >> 1, fpm, fpn);
                conv_fixup(ws, pp->w_conv + (size_t)l * 3 * DFF2, pp->b_conv + (size_t)l * DFF2, fpm, (u & 1) * (DFF / 2));
            }
            EpiBf E{(bf16_t*)(ws + OFF_P), (bf16_t*)(ws + OFF_P1), 1024};
            RUN_GEMM(gemm_run(S, 32, 4, E, ldsh);)
        }
        xcd_barrier(xb);
    }
    RUN_NORM(phase_norm(kp, 2, 4, 1, 1 * 8 + 5, 0, 0);)
}

extern "C" void kernel_launch(void* const* d_in, const int* in_sizes, int n_in, void* d_out, int out_size, void* d_ws, size_t ws_size, hipStream_t stream) {
    static int grid_blocks = 0;
    if (!grid_blocks) {
        int dev = 0, cus = 0, per_cu = 0;
        hipGetDevice(&dev);
        hipDeviceGetAttribute(&cus, hipDeviceAttributeMultiprocessorCount, dev);
        if (hipFuncSetAttribute((const void*)fwd_megakernel, hipFuncAttributeMaxDynamicSharedMemorySize, LDS_BYTES) != hipSuccess) fprintf(stderr, "hipFuncSetAttribute failed\n");
        if (hipOccupancyMaxActiveBlocksPerMultiprocessor(&per_cu, (const void*)fwd_megakernel, NTHR, LDS_BYTES) != hipSuccess || per_cu < 1) fprintf(stderr, "occupancy query: %d per CU\n", per_cu);
        (void)hipGetLastError();
        grid_blocks = cus;
        if (ws_size < WS_END) fprintf(stderr, "workspace too small: %zu < %zu\n", ws_size, (size_t)WS_END);
    }
    Params p{};
    p.x_prompt = (const float*)d_in[0]; p.x_sample = (const float*)d_in[1]; p.state_hgrn = (const float*)d_in[2]; p.state_ret = (const float*)d_in[3];
    p.c = (const float*)d_in[4]; p.c_ctx = (const float*)d_in[5]; p.norm1 = (const float*)d_in[6]; p.norm2 = (const float*)d_in[7]; p.final_norm = (const float*)d_in[8];
    p.w_mod = (const float*)d_in[9]; p.b_mod = (const float*)d_in[10]; p.w_in = (const float*)d_in[11]; p.lb_raw = (const float*)d_in[12];
    p.p_a = (const float*)d_in[13]; p.p_b = (const float*)d_in[14]; p.w_out = (const float*)d_in[15]; p.w_up = (const float*)d_in[16];
    p.w_conv = (const float*)d_in[17]; p.b_conv = (const float*)d_in[18]; p.w_down = (const float*)d_in[19];
    p.out = (float*)d_out; p.ws = (unsigned char*)d_ws;
    (void)hipMemsetAsync((unsigned char*)d_ws + OFF_BAR, 0, 16384, stream);
    void* args[] = {&p};
    hipError_t e = hipLaunchCooperativeKernel((void*)fwd_megakernel, dim3(grid_blocks), dim3(NTHR), args, LDS_BYTES, stream);
    if (e != hipSuccess) fprintf(stderr, "cooperative launch failed: %s (grid %d)\n", hipGetErrorString(e), grid_blocks);
}
```
